# Optimizing an MI355X kernel written in HIP

```python
import math
import numpy as np
import jax
import jax.numpy as jnp
from jax import lax

D_MODEL = 1024
BATCH = 4
SEQ = 8192
DEPTH = 4

GRID_W = 64
CTX_LEN = 256
N_DIRS = 2
EPS = 1e-6
S5_WIDTH = D_MODEL // 2
S5_GROUP = 16
S5_GROUPS = S5_WIDTH // S5_GROUP
S5_STATE = 64
DT_MIN = 1e-3
DT_MAX = 1e-1
GLA_HEADS = 4
GLA_DV = D_MODEL // 2 // GLA_HEADS
GLA_DK = GLA_DV // 2
GLA_WIDTH = GLA_HEADS * GLA_DV
GLA_KEY = GLA_HEADS * GLA_DK
GLA_RANK = 16
GLA_NORMALIZER = 16.0
GLA_CHUNK = 64
MIX_WIDTH = S5_WIDTH + GLA_WIDTH
IN_WIDTH = 2 * S5_WIDTH + 2 * GLA_KEY + 2 * GLA_WIDTH + N_DIRS * GLA_RANK

kernel_name = 'hybrid_s5_gla_prefix_dit'


def _split_points():
    sizes = (S5_WIDTH, S5_WIDTH, GLA_KEY, GLA_KEY, GLA_WIDTH, GLA_WIDTH, N_DIRS * GLA_RANK)
    return [int(v) for v in np.cumsum(sizes)[:-1]]


def rms_norm(x, gain):
    xf = x.astype(jnp.float32)
    y = xf * lax.rsqrt(jnp.mean(xf * xf, axis=-1, keepdims=True) + EPS)
    return (y * gain.astype(jnp.float32)).astype(x.dtype)


def modulation(cond, w_mod, b_mod):
    m = jax.nn.silu(cond) @ w_mod + b_mod
    return jnp.split(m, 3, axis=-1)


def _flip(t, rev):
    return t[:, ::-1] if rev else t


def to_colmajor(t, rows):
    b, l = t.shape[:2]
    return t.reshape(b, rows, GRID_W, *t.shape[2:]).swapaxes(1, 2).reshape(b, l, *t.shape[2:])


def from_colmajor(t, rows):
    b, l = t.shape[:2]
    return t.reshape(b, GRID_W, rows, *t.shape[2:]).swapaxes(1, 2).reshape(b, l, *t.shape[2:])


def _lin_combine(e1, e2):
    a1, b1 = e1
    a2, b2 = e2
    return a2 * a1, a2 * b1 + b2


def s5_scan(lam_bar, bu, h0):
    a = jnp.broadcast_to(lam_bar, bu.shape)
    a_cum, h = lax.associative_scan(_lin_combine, (a, bu), axis=1)
    if h0 is None:
        return h
    return h + a_cum * h0[:, None]


def s5_discretize(lam_re, lam_im, log_dt, b_cplx):
    lam = lax.complex(lam_re.astype(jnp.float32), lam_im.astype(jnp.float32))
    dt = jnp.exp(log_dt.astype(jnp.float32))[:, None]
    lam_bar = jnp.exp(lam * dt)
    b_bar = ((lam_bar - 1.0) / lam)[..., None] * b_cplx
    return lam_bar, b_bar


def s5_branch(u_c, u_l, lam_re, lam_im, log_dt, b_re, b_im, c_re, c_im, d_skip, w_glu, b_glu, need_ctx):
    dtype = u_l.dtype
    grp = lambda u: u.astype(jnp.float32).reshape(*u.shape[:2], S5_GROUPS, S5_GROUP)
    uc, ul = grp(u_c), grp(u_l)
    b_cplx = lax.complex(b_re.astype(jnp.float32), b_im.astype(jnp.float32))
    h_c = 0.0
    h_l = 0.0
    for d in range(N_DIRS):
        rev = d == 1
        lam_bar, b_bar = s5_discretize(lam_re[d], lam_im[d], log_dt[d], b_cplx)
        hc = s5_scan(lam_bar, jnp.einsum('gnp,blgp->blgn', b_bar, _flip(uc, rev)), None)
        hl = s5_scan(lam_bar, jnp.einsum('gnp,blgp->blgn', b_bar, _flip(ul, rev)), hc[:, -1])
        h_c = h_c + _flip(hc, rev)
        h_l = h_l + _flip(hl, rev)
    c_cplx = lax.complex(c_re.astype(jnp.float32), c_im.astype(jnp.float32))
    d_g = d_skip.astype(jnp.float32).reshape(S5_GROUPS, S5_GROUP)

    def readout(h, u):
        y = jnp.einsum('gpn,blgn->blgp', c_cplx, h).real + d_g * u
        y = jax.nn.gelu(y.reshape(*u.shape[:2], S5_WIDTH)).astype(dtype)
        return y * jax.nn.sigmoid(y @ w_glu + b_glu)

    y_c = readout(h_c, uc) if need_ctx else None
    return y_c, readout(h_l, ul)


def gla_chunked(q, k, v, g, s0):
    bsz, l, h, dk = q.shape
    dv = v.shape[-1]
    n = l // GLA_CHUNK
    chunks = lambda t: t.astype(jnp.float32).reshape(bsz, n, GLA_CHUNK, h, t.shape[-1])
    q, k, v, g = chunks(q), chunks(k), chunks(v), chunks(g)
    gc = jnp.cumsum(g, axis=2)
    g_last = gc[:, :, -1]
    q_t = q * jnp.exp(gc)
    k_t = k * jnp.exp(-gc)
    scores = jnp.einsum('bnihd,bnjhd->bnhij', q_t, k_t)
    mask = jnp.tril(jnp.ones((GLA_CHUNK, GLA_CHUNK), dtype=bool))
    scores = jnp.where(mask, scores, 0.0)
    o = jnp.einsum('bnhij,bnjhv->bnihv', scores, v)
    ds = jnp.einsum('bnjhd,bnjhv->bnhdv', k * jnp.exp(g_last[:, :, None] - gc), v)
    decay = jnp.exp(g_last)
    if s0 is None:
        s0 = jnp.zeros((bsz, h, dk, dv), jnp.float32)

    def step(s, inp):
        dec, d_s = inp
        return dec[..., None] * s + d_s, s

    s_final, s_in = lax.scan(step, s0, (jnp.moveaxis(decay, 1, 0), jnp.moveaxis(ds, 1, 0)))
    s_in = jnp.moveaxis(s_in, 0, 1)
    o = o + jnp.einsum('bnihd,bnhdv->bnihv', q_t, s_in)
    return o.reshape(bsz, l, h, dv), s_final


def gla_log_decay(lr, w_gate, b_gate, d):
    z = lr[..., d * GLA_RANK:(d + 1) * GLA_RANK] @ w_gate[d] + b_gate[d]
    g = jax.nn.log_sigmoid(z.astype(jnp.float32)) / GLA_NORMALIZER
    return g.reshape(*g.shape[:2], GLA_HEADS, GLA_DK)


def gla_branch(q_c, k_c, v_c, lr_c, q_l, k_l, v_l, lr_l, w_gate, b_gate, norm_g, need_ctx):
    dtype = q_l.dtype
    heads = lambda t, dd: t.reshape(*t.shape[:2], GLA_HEADS, dd)
    q_c, q_l = heads(q_c, GLA_DK) * GLA_DK ** -0.5, heads(q_l, GLA_DK) * GLA_DK ** -0.5
    k_c, k_l = heads(k_c, GLA_DK), heads(k_l, GLA_DK)
    v_c, v_l = heads(v_c, GLA_DV), heads(v_l, GLA_DV)
    o_c = 0.0
    o_l = 0.0
    for d in range(N_DIRS):
        rev = d == 1
        g_c = gla_log_decay(lr_c, w_gate, b_gate, d)
        g_l = gla_log_decay(lr_l, w_gate, b_gate, d)
        oc, s_c = gla_chunked(_flip(q_c, rev), _flip(k_c, rev), _flip(v_c, rev), _flip(g_c, rev), None)
        ol, _ = gla_chunked(_flip(q_l, rev), _flip(k_l, rev), _flip(v_l, rev), _flip(g_l, rev), s_c)
        o_c = o_c + _flip(oc, rev)
        o_l = o_l + _flip(ol, rev)

    def finish(o):
        return rms_norm(o, norm_g).reshape(*o.shape[:2], GLA_WIDTH).astype(dtype)

    y_c = finish(o_c) if need_ctx else None
    return y_c, finish(o_l)


def hybrid_layer(x_lat, x_ctx, c, c_ctx, norm_g, w_mod, b_mod, w_in, lam_re, lam_im, log_dt, b_re, b_im,
                 c_re, c_im, d_skip, w_glu, b_glu, gla_w_gate, gla_b_gate, gla_norm_g, w_out, need_ctx_out):
    rows = x_lat.shape[1] // GRID_W
    sh_l, sc_l, gt_l = modulation(c, w_mod, b_mod)
    sh_c, sc_c, gt_c = modulation(c_ctx, w_mod, b_mod)
    h_l = rms_norm(x_lat, norm_g) * (1.0 + sc_l[:, None]) + sh_l[:, None]
    h_c = rms_norm(x_ctx, norm_g) * (1.0 + sc_c) + sh_c
    sp = _split_points()
    u_l, zs_l, q_l, k_l, v_l, zg_l, lr_l = jnp.split(h_l @ w_in, sp, axis=-1)
    u_c, zs_c, q_c, k_c, v_c, zg_c, lr_c = jnp.split(h_c @ w_in, sp, axis=-1)

    ys_c, ys_l = s5_branch(u_c, u_l, lam_re, lam_im, log_dt, b_re, b_im, c_re, c_im, d_skip, w_glu, b_glu,
                           need_ctx_out)
    cm = lambda t: to_colmajor(t, rows)
    yg_c, yg_l = gla_branch(q_c, k_c, v_c, lr_c, cm(q_l), cm(k_l), cm(v_l), cm(lr_l),
                            gla_w_gate, gla_b_gate, gla_norm_g, need_ctx_out)
    yg_l = from_colmajor(yg_l, rows)

    y_l = jnp.concatenate([ys_l * jax.nn.silu(zs_l), yg_l * jax.nn.silu(zg_l)], axis=-1) @ w_out
    x_lat = x_lat + gt_l[:, None] * y_l
    if need_ctx_out:
        y_c = jnp.concatenate([ys_c * jax.nn.silu(zs_c), yg_c * jax.nn.silu(zg_c)], axis=-1) @ w_out
        x_ctx = x_ctx + gt_c * y_c
    return x_lat, x_ctx


def setup_inputs(seed: int = 0) -> dict:
    key = jax.random.key(seed)
    ks = jax.random.split(key, 24)
    f32 = jnp.float32
    nrm = lambda k, shape, s: s * jax.random.normal(k, shape, f32)
    return {
        'x': nrm(ks[0], (BATCH, SEQ, D_MODEL), 1.0),
        'c': nrm(ks[1], (BATCH, D_MODEL), 1.0),
        'ctx': nrm(ks[2], (BATCH, CTX_LEN, D_MODEL), 1.0),
        'c_ctx': nrm(ks[3], (D_MODEL,), 1.0),
        'norm_g': 1.0 + nrm(ks[4], (DEPTH, D_MODEL), 0.02),
        'w_mod': nrm(ks[5], (DEPTH, D_MODEL, 3 * D_MODEL), 0.5 * D_MODEL ** -0.5),
        'b_mod': nrm(ks[6], (DEPTH, 3 * D_MODEL), 0.02),
        'w_in': nrm(ks[7], (DEPTH, D_MODEL, IN_WIDTH), D_MODEL ** -0.5),
        's5_lam_re': jnp.full((DEPTH, N_DIRS, S5_GROUPS, S5_STATE), -0.5, f32),
        's5_lam_im': jnp.broadcast_to(math.pi * jnp.arange(S5_STATE, dtype=f32),
                                      (DEPTH, N_DIRS, S5_GROUPS, S5_STATE)),
        's5_log_dt': jax.random.uniform(ks[8], (DEPTH, N_DIRS, S5_GROUPS), f32,
                                        math.log(DT_MIN), math.log(DT_MAX)),
        's5_b_re': nrm(ks[9], (DEPTH, S5_GROUPS, S5_STATE, S5_GROUP), (2 * S5_GROUP) ** -0.5),
        's5_b_im': nrm(ks[10], (DEPTH, S5_GROUPS, S5_STATE, S5_GROUP), (2 * S5_GROUP) ** -0.5),
        's5_c_re': nrm(ks[11], (DEPTH, S5_GROUPS, S5_GROUP, S5_STATE), S5_STATE ** -0.5),
        's5_c_im': nrm(ks[12], (DEPTH, S5_GROUPS, S5_GROUP, S5_STATE), S5_STATE ** -0.5),
        's5_d': nrm(ks[13], (DEPTH, S5_WIDTH), 1.0),
        's5_w_glu': nrm(ks[14], (DEPTH, S5_WIDTH, S5_WIDTH), S5_WIDTH ** -0.5),
        's5_b_glu': nrm(ks[15], (DEPTH, S5_WIDTH), 0.02),
        'gla_w_gate': nrm(ks[16], (DEPTH, N_DIRS, GLA_RANK, GLA_KEY), GLA_RANK ** -0.5),
        'gla_b_gate': nrm(ks[17], (DEPTH, N_DIRS, GLA_KEY), 0.1),
        'gla_norm_g': 1.0 + nrm(ks[18], (DEPTH, GLA_DV), 0.02),
        'w_out': nrm(ks[19], (DEPTH, MIX_WIDTH, D_MODEL), MIX_WIDTH ** -0.5),
        'final_norm': 1.0 + nrm(ks[20], (D_MODEL,), 0.02),
    }


def reference(x, c, ctx, c_ctx, norm_g, w_mod, b_mod, w_in, s5_lam_re, s5_lam_im, s5_log_dt, s5_b_re, s5_b_im,
              s5_c_re, s5_c_im, s5_d, s5_w_glu, s5_b_glu, gla_w_gate, gla_b_gate, gla_norm_g, w_out, final_norm):
    x_lat, x_ctx = x, ctx
    for i in range(DEPTH):
        x_lat, x_ctx = hybrid_layer(
            x_lat, x_ctx, c, c_ctx, norm_g[i], w_mod[i], b_mod[i], w_in[i],
            s5_lam_re[i], s5_lam_im[i], s5_log_dt[i], s5_b_re[i], s5_b_im[i], s5_c_re[i], s5_c_im[i],
            s5_d[i], s5_w_glu[i], s5_b_glu[i], gla_w_gate[i], gla_b_gate[i], gla_norm_g[i], w_out[i],
            need_ctx_out=(i < DEPTH - 1))
    return rms_norm(x_lat, final_norm)
```

```cpp
#include <hip/hip_runtime.h>
#include <hip/hip_cooperative_groups.h>
#include <cstdio>
#include <cstdint>
namespace cg = cooperative_groups;

typedef unsigned short bf16_t;
typedef short bf16x8 __attribute__((ext_vector_type(8)));
typedef float f32x16 __attribute__((ext_vector_type(16)));

#define DEV __device__ __forceinline__
#define LAS __attribute__((address_space(3)))

#ifndef PHMASK
#define PHMASK 0x1ff
#endif
#ifndef REPMASK
#define REPMASK 0
#endif
#ifndef SYNCX
#define SYNCX 0
#endif
#ifndef REPG0
#define REPG0 0
#endif
#ifndef REPD
#define REPD 0
#endif
#ifndef REPP0
#define REPP0 0
#endif
#ifndef EPI_UNROLL
#define EPI_UNROLL 4
#endif
#ifndef MULTI_LAUNCH
#define MULTI_LAUNCH 0
#endif

constexpr int D = 1024, NB = 4, SEQ = 8192, DEPTH = 4, CTXL = 256;
constexpr int NCTX = NB * CTXL;
constexpr int NTOK = NCTX + NB * SEQ;
constexpr int INW = 2592, PW = 2080;
constexpr int NSUB = NTOK / 32;
constexpr int NCH = 132;
constexpr int NTHREADS = 256;
constexpr int LDS_MAIN = 75264;
constexpr int LDS_BYTES = LDS_MAIN + 16;
constexpr int NPHASE = 2 + 7 * DEPTH;

constexpr size_t OFF_XCTX = 0;
constexpr size_t OFF_HMIX = OFF_XCTX + (size_t)NCTX * D * 4;
constexpr size_t OFF_PBUF = OFF_HMIX + (size_t)NTOK * D * 2;
constexpr size_t OFF_ABUF = OFF_PBUF + (size_t)NTOK * PW * 2;
constexpr size_t OFF_HY   = OFF_ABUF + (size_t)32 * NSUB * 768 * 2;
constexpr size_t OFF_DS   = OFF_HY + (size_t)32 * NSUB * 256 * 4;
constexpr size_t OFF_XB   = OFF_DS + (size_t)32 * NCH * 8192 * 2;
constexpr size_t OFF_DEC  = OFF_DS + (size_t)32 * NCH * 8192 * 4;
constexpr size_t OFF_WIN  = OFF_DEC + (size_t)32 * NCH * 64 * 4;
constexpr size_t OFF_WOUT = OFF_WIN + (size_t)DEPTH * INW * D * 2;
constexpr size_t OFF_WGLU = OFF_WOUT + (size_t)DEPTH * D * D * 2;
constexpr size_t OFF_MY   = OFF_WGLU + (size_t)DEPTH * 512 * 512 * 2;
constexpr size_t OFF_MH   = OFF_MY + (size_t)32 * 512 * 768 * 2;
constexpr size_t OFF_KTAB = OFF_MH + (size_t)32 * 256 * 512 * 2;
constexpr size_t OFF_LR   = OFF_KTAB + (size_t)DEPTH * 32 * 2 * 32 * 256 * 4;
constexpr size_t OFF_MOD  = OFF_LR + (size_t)NTOK * 32 * 4;
constexpr size_t OFF_LAMT = OFF_MOD + (size_t)DEPTH * 5 * 3072 * 4;
constexpr size_t OFF_BAR  = OFF_LAMT + (size_t)DEPTH * 2 * 32 * 64 * 2 * 4;
constexpr size_t OFF_DTAB = OFF_BAR + 3456 * 4 + 256;
constexpr size_t WS_END   = OFF_DTAB + (size_t)DEPTH * 2 * 32 * 64 * 16;

struct Params {
    const float* in[23];
    float* out;
    unsigned char* ws;
};
enum { I_X = 0, I_C, I_CTX, I_CCTX, I_NORMG, I_WMOD, I_BMOD, I_WIN, I_LAMRE, I_LAMIM, I_LOGDT, I_BRE, I_BIM, I_CRE, I_CIM, I_SD, I_WGLU, I_BGLU,
       I_WGATE, I_BGATE, I_GNORM, I_WOUT, I_FNORM };

DEV bf16_t f2bf(float f) { unsigned u = __float_as_uint(f); u += 0x7fffu + ((u >> 16) & 1u); return (bf16_t)(u >> 16); }
DEV float bf2f(bf16_t h) { return __uint_as_float(((unsigned)h) << 16); }
DEV unsigned pack2(float a, float b) { return (unsigned)f2bf(a) | ((unsigned)f2bf(b) << 16); }
DEV float sigmoidf_(float x) { return __builtin_amdgcn_rcpf(1.f + __builtin_amdgcn_exp2f(x * -1.4426950408889634f)); }
DEV float siluf_(float x) { return x * sigmoidf_(x); }
DEV float gelu_tanh(float x) { float u = 0.7978845608028654f * (x + 0.044715f * x * x * x); return x * sigmoidf_(2.f * u); }
DEV void sincos_rev(float rev, float& s, float& c) { float f = rev - floorf(rev); s = __builtin_amdgcn_sinf(f); c = __builtin_amdgcn_cosf(f); }

struct Disc { float a, rev, cr, ci; };
DEV Disc s5_disc(const Params& P, int l, int d, int g, int n) {
    const int idx = ((l * 2 + d) * 32 + g) * 64 + n;
    const float lr = P.in[I_LAMRE][idx], li = P.in[I_LAMIM][idx];
    const float dt = expf(P.in[I_LOGDT][(l * 2 + d) * 32 + g]);
    Disc o; o.a = lr * dt; const float w = li * dt; o.rev = w * 0.15915494309189535f;
    float s, c, sh, ch; sincos_rev(o.rev, s, c); sincos_rev(0.5f * o.rev, sh, ch);
    const float em1 = expm1f(o.a);
    const float br = em1 * c - 2.f * sh * sh, bi = (em1 + 1.f) * s;
    const float den = lr * lr + li * li;
    o.cr = (br * lr + bi * li) / den; o.ci = (bi * lr - br * li) / den;
    return o;
}
DEV Disc s5_disc_tab(const Params& P, int l, int d, int g, int n) {
    const float4 t = ((const float4*)(P.ws + OFF_DTAB))[((l * 2 + d) * 32 + g) * 64 + n];
    Disc o; o.a = t.x; o.rev = t.y; o.cr = t.z; o.ci = t.w; return o;
}
DEV void cpow(const Disc& dc, float k, float& pr, float& pi) { const float e = __expf(k * dc.a); float s, c; sincos_rev(k * dc.rev, s, c); pr = e * c; pi = e * s; }

DEV const float* xrow_c(const Params& P, int l, int row) {
    if (l == 0) return row < NCTX ? P.in[I_CTX] + (size_t)row * D : P.in[I_X] + (size_t)(row - NCTX) * D;
    return row < NCTX ? (const float*)(P.ws + OFF_XCTX) + (size_t)row * D : P.out + (size_t)(row - NCTX) * D;
}
DEV float* xrow_w(const Params& P, int row) { return row < NCTX ? (float*)(P.ws + OFF_XCTX) + (size_t)row * D : P.out + (size_t)(row - NCTX) * D; }
DEV int mod_row(int row) { return row < NCTX ? 4 : ((row - NCTX) >> 13); }

struct GemmDesc { const bf16_t* A; size_t lda; int M; const bf16_t* B; size_t ldb; int N; int K; };

#define GR_PARAMS uint4& r0a0, uint4& r0a1, uint4& r0a2, uint4& r0a3, uint4& r0b0, uint4& r0b1, uint4& r0b2, uint4& r0b3, uint4& r1a0, uint4& r1a1, uint4& r1a2, uint4& r1a3, uint4& r1b0, uint4& r1b1, uint4& r1b2, uint4& r1b3, uint4& r2a0, uint4& r2a1, uint4& r2a2, uint4& r2a3, uint4& r2b0, uint4& r2b1, uint4& r2b2, uint4& r2b3
#define GR_ARGS r0a0, r0a1, r0a2, r0a3, r0b0, r0b1, r0b2, r0b3, r1a0, r1a1, r1a2, r1a3, r1b0, r1b1, r1b2, r1b3, r2a0, r2a1, r2a2, r2a3, r2b0, r2b1, r2b2, r2b3
#define GR_DECL uint4 r0a0 = make_uint4(0u, 0u, 0u, 0u), r0a1 = make_uint4(0u, 0u, 0u, 0u), r0a2 = make_uint4(0u, 0u, 0u, 0u), r0a3 = make_uint4(0u, 0u, 0u, 0u), r0b0 = make_uint4(0u, 0u, 0u, 0u), r0b1 = make_uint4(0u, 0u, 0u, 0u), r0b2 = make_uint4(0u, 0u, 0u, 0u), r0b3 = make_uint4(0u, 0u, 0u, 0u), r1a0 = make_uint4(0u, 0u, 0u, 0u), r1a1 = make_uint4(0u, 0u, 0u, 0u), r1a2 = make_uint4(0u, 0u, 0u, 0u), r1a3 = make_uint4(0u, 0u, 0u, 0u), r1b0 = make_uint4(0u, 0u, 0u, 0u), r1b1 = make_uint4(0u, 0u, 0u, 0u), r1b2 = make_uint4(0u, 0u, 0u, 0u), r1b3 = make_uint4(0u, 0u, 0u, 0u), r2a0 = make_uint4(0u, 0u, 0u, 0u), r2a1 = make_uint4(0u, 0u, 0u, 0u), r2a2 = make_uint4(0u, 0u, 0u, 0u), r2a3 = make_uint4(0u, 0u, 0u, 0u), r2b0 = make_uint4(0u, 0u, 0u, 0u), r2b1 = make_uint4(0u, 0u, 0u, 0u), r2b2 = make_uint4(0u, 0u, 0u, 0u), r2b3 = make_uint4(0u, 0u, 0u, 0u);
template <class Epi>
DEV void gemm_tile(const GemmDesc& G, int m0, int n0, const Epi& epi, GR_PARAMS, bool preloaded, bool has_next, const GemmDesc& Gn, int m0n, int n0n, unsigned char* smem, int tid) {
    bf16_t* sA = (bf16_t*)smem;
    bf16_t* sB = sA + 2 * 128 * 72;
    const int lane = tid & 63, wave = tid >> 6, wm = wave >> 1, wn = wave & 1;
    const int lr = tid >> 3, kc = (tid & 7) * 8;
    const bf16_t* Abase = G.A + ((size_t)(m0 + lr) * G.lda + kc); const bf16_t* Bbase = G.B + ((size_t)(n0 + lr) * G.ldb + kc);
    const unsigned sa32 = 32u * (unsigned)G.lda, sb32 = 32u * (unsigned)G.ldb;
    f32x16 acc[2][2];
#pragma unroll
    for (int i = 0; i < 2; ++i)
#pragma unroll
        for (int j = 0; j < 2; ++j)
#pragma unroll
            for (int r = 0; r < 16; ++r) acc[i][j][r] = 0.f;
    const int nk = G.K >> 6;
    const int fr = lane & 31, fh = (lane >> 5) * 8;
#define G_LOAD(RA, RB, KT) { G_LOADH0(RA, RB, KT) G_LOADH1(RA, RB, KT) }
#define G_LOADH0(RA, RB, KT) { unsigned sa_ = sa32, sb_ = sb32; asm volatile("" : "+s"(sa_)); asm volatile("" : "+s"(sb_)); \
        const bf16_t* pa_ = Abase + (KT) * 64; const bf16_t* pb_ = Bbase + (KT) * 64; \
        RA##0 = *(const uint4*)(pa_); RB##0 = *(const uint4*)(pb_); RA##1 = *(const uint4*)(pa_ + sa_); RB##1 = *(const uint4*)(pb_ + sb_); }
#define G_LOADH1(RA, RB, KT) { unsigned sa_ = sa32, sb_ = sb32; asm volatile("" : "+s"(sa_)); asm volatile("" : "+s"(sb_)); \
        const bf16_t* pa_ = Abase + (KT) * 64; const bf16_t* pb_ = Bbase + (KT) * 64; \
        RA##2 = *(const uint4*)(pa_ + 2 * sa_); RB##2 = *(const uint4*)(pb_ + 2 * sb_); RA##3 = *(const uint4*)(pa_ + 3 * sa_); RB##3 = *(const uint4*)(pb_ + 3 * sb_); }
#define G_STORE(RA, RB, BUF) { G_STOREH0(RA, RB, BUF) G_STOREH1(RA, RB, BUF) }
#define G_STOREH0(RA, RB, BUF) { bf16_t* dA = sA + (BUF) * (128 * 72); bf16_t* dB = sB + (BUF) * (128 * 72); \
        *(uint4*)(dA + (lr) * 72 + kc) = RA##0; *(uint4*)(dB + (lr) * 72 + kc) = RB##0; *(uint4*)(dA + (lr + 32) * 72 + kc) = RA##1; *(uint4*)(dB + (lr + 32) * 72 + kc) = RB##1; }
#define G_STOREH1(RA, RB, BUF) { bf16_t* dA = sA + (BUF) * (128 * 72); bf16_t* dB = sB + (BUF) * (128 * 72); \
        *(uint4*)(dA + (lr + 64) * 72 + kc) = RA##2; *(uint4*)(dB + (lr + 64) * 72 + kc) = RB##2; *(uint4*)(dA + (lr + 96) * 72 + kc) = RA##3; *(uint4*)(dB + (lr + 96) * 72 + kc) = RB##3; }
#define G_LDA0(KS) { fa0 = *(const bf16x8*)(cA + (KS) * 16); }
#define G_LDA1(KS) { fa1 = *(const bf16x8*)(cA + 32 * 72 + (KS) * 16); }
#define G_LDB(KS, B0, B1) { B0 = *(const bf16x8*)(cB + (KS) * 16); B1 = *(const bf16x8*)(cB + 32 * 72 + (KS) * 16); }
#define G_MM0(B0, B1) { acc[0][0] = __builtin_amdgcn_mfma_f32_32x32x16_bf16(B0, fa0, acc[0][0], 0, 0, 0); acc[0][1] = __builtin_amdgcn_mfma_f32_32x32x16_bf16(B1, fa0, acc[0][1], 0, 0, 0); }
#define G_MM1(B0, B1) { acc[1][0] = __builtin_amdgcn_mfma_f32_32x32x16_bf16(B0, fa1, acc[1][0], 0, 0, 0); acc[1][1] = __builtin_amdgcn_mfma_f32_32x32x16_bf16(B1, fa1, acc[1][1], 0, 0, 0); }
#define G_SB __builtin_amdgcn_sched_barrier(0);
#define G_STEP(RA, RB, KT) { \
        const bf16_t* cA = sA + ((KT) & 1) * (128 * 72) + (wm * 64 + fr) * 72 + fh; \
        const bf16_t* cB = sB + ((KT) & 1) * (128 * 72) + (wn * 64 + fr) * 72 + fh; \
        bf16x8 fa0, fa1, xb0, xb1, yb0, yb1; \
        G_LDA0(0) G_LDB(0, xb0, xb1) G_LDA1(0) G_LDB(1, yb0, yb1) G_SB \
        G_MM0(xb0, xb1) G_SB G_LDA0(1) G_SB G_MM1(xb0, xb1) G_SB G_LDA1(1) G_LDB(2, xb0, xb1) G_SB \
        if ((KT) + 1 < nk) G_STOREH0(RA, RB, ((KT) + 1) & 1) \
        if ((KT) + 4 < nk) G_LOADH0(RA, RB, (KT) + 4) \
        G_SB G_MM0(yb0, yb1) G_SB G_LDA0(2) G_SB G_MM1(yb0, yb1) G_SB G_LDA1(2) G_LDB(3, yb0, yb1) G_SB \
        if ((KT) + 1 < nk) G_STOREH1(RA, RB, ((KT) + 1) & 1) \
        if ((KT) + 4 < nk) G_LOADH1(RA, RB, (KT) + 4) \
        G_SB G_MM0(xb0, xb1) G_SB G_LDA0(3) G_SB G_MM1(xb0, xb1) G_SB G_LDA1(3) G_SB \
        G_MM0(yb0, yb1) G_MM1(yb0, yb1) G_SB \
        __syncthreads(); }
    if (!preloaded) { G_LOAD(r0a, r0b, 0) G_LOAD(r1a, r1b, 1) G_LOAD(r2a, r2b, 2) }
    G_STORE(r0a, r0b, 0)
    __syncthreads();
    G_LOAD(r0a, r0b, 3)
    for (int kt = 0; kt < nk; kt += 3) {
        G_STEP(r1a, r1b, kt)
        if (kt + 1 < nk) G_STEP(r2a, r2b, kt + 1)
        if (kt + 2 < nk) G_STEP(r0a, r0b, kt + 2)
    }
    if (has_next) {
        const bf16_t* Abase = Gn.A + ((size_t)(m0n + lr) * Gn.lda + kc); const bf16_t* Bbase = Gn.B + ((size_t)(n0n + lr) * Gn.ldb + kc);
        const unsigned sa32 = 32u * (unsigned)Gn.lda, sb32 = 32u * (unsigned)Gn.ldb;
        G_LOAD(r0a, r0b, 0) G_LOAD(r1a, r1b, 1) G_LOAD(r2a, r2b, 2)
    }
#undef G_LOAD
#undef G_STORE
#undef G_STEP
#undef G_LDA0
#undef G_LDA1
#undef G_LDB
#undef G_MM0
#undef G_MM1
#undef G_LOADH0
#undef G_LOADH1
#undef G_STOREH0
#undef G_STOREH1
#undef G_SB
    float* sC = (float*)smem;
    int te = tid; asm volatile("" : "+v"(te));
    const int lane_e = te & 63, wave_e = te >> 6, wm_e = wave_e >> 1, wn_e = wave_e & 1, fr_e = lane_e & 31;
#pragma unroll
    for (int i = 0; i < 2; ++i)
#pragma unroll
        for (int j = 0; j < 2; ++j)
#pragma unroll
            for (int g = 0; g < 4; ++g) {
                float4 v; v.x = acc[i][j][4 * g]; v.y = acc[i][j][4 * g + 1]; v.z = acc[i][j][4 * g + 2]; v.w = acc[i][j][4 * g + 3];
                *(float4*)(sC + (wm_e * 64 + i * 32 + fr_e) * 132 + wn_e * 64 + j * 32 + 8 * g + 4 * (lane_e >> 5)) = v;
            }
    __syncthreads();
#pragma unroll EPI_UNROLL
    for (int u = 0; u < 8; ++u) {
        const int c = te + 256 * u, ml = c >> 4, n8 = (c & 15) * 8;
        const float4 v0 = *(const float4*)(sC + ml * 132 + n8), v1 = *(const float4*)(sC + ml * 132 + n8 + 4);
        if (m0 + ml < G.M && n0 + n8 < G.N) epi.vec(m0 + ml, n0 + n8, v0, v1);
    }
    __syncthreads();
}

DEV uint4 pack8(const float4& a, const float4& b) { uint4 o; o.x = pack2(a.x, a.y); o.y = pack2(a.z, a.w); o.z = pack2(b.x, b.y); o.w = pack2(b.z, b.w); return o; }
DEV void unpack8(const uint4& w, float* f) {
    f[0] = __uint_as_float(w.x << 16); f[1] = __uint_as_float(w.x & 0xffff0000u); f[2] = __uint_as_float(w.y << 16); f[3] = __uint_as_float(w.y & 0xffff0000u);
    f[4] = __uint_as_float(w.z << 16); f[5] = __uint_as_float(w.z & 0xffff0000u); f[6] = __uint_as_float(w.w << 16); f[7] = __uint_as_float(w.w & 0xffff0000u);
}
struct EpiInProj {
    bf16_t* abuf; bf16_t* pbuf; float* lrbuf;
    DEV void vec(int m, int n, const float4& a, const float4& b) const {
        const uint4 o = pack8(a, b);
        if (n < 512) *(uint4*)(abuf + ((size_t)(n >> 4) * NSUB + (m >> 5)) * 768 + (m & 31) * 16 + (n & 15)) = o;
        else { *(uint4*)(pbuf + (size_t)m * PW + (n - 512)) = o;
            if (n >= 2560) { *(float4*)(lrbuf + (size_t)m * 32 + (n - 2560)) = a; *(float4*)(lrbuf + (size_t)m * 32 + (n - 2560) + 4) = b; } }
    }
};
struct EpiHloc {
    float* hloc;
    DEV void vec(int m, int n, const float4& a, const float4& b) const { *(float4*)(hloc + (size_t)m * 256 + n) = a; *(float4*)(hloc + (size_t)m * 256 + n + 4) = b; }
};
struct EpiS5Out {
    bf16_t* ybuf; int g;
    DEV void vec(int m, int n, const float4& a, const float4& b) const {
        float4 ga, gb; ga.x = gelu_tanh(a.x); ga.y = gelu_tanh(a.y); ga.z = gelu_tanh(a.z); ga.w = gelu_tanh(a.w); gb.x = gelu_tanh(b.x); gb.y = gelu_tanh(b.y); gb.z = gelu_tanh(b.z); gb.w = gelu_tanh(b.w);
        *(uint4*)(ybuf + ((size_t)m * 32 + (n >> 4)) * 512 + g * 16 + (n & 15)) = pack8(ga, gb);
    }
};
struct EpiGlu {
    const bf16_t* ybuf; const bf16_t* pbuf; const float* bglu; bf16_t* mix;
    DEV void vec(int m, int n, const float4& a, const float4& b) const {
        float y[8], z[8]; unpack8(*(const uint4*)(ybuf + (size_t)m * 512 + n), y); unpack8(*(const uint4*)(pbuf + (size_t)m * PW + n), z);
        const float4 b0 = *(const float4*)(bglu + n), b1 = *(const float4*)(bglu + n + 4);
        float4 oa, ob;
        oa.x = y[0] * sigmoidf_(a.x + b0.x) * siluf_(z[0]); oa.y = y[1] * sigmoidf_(a.y + b0.y) * siluf_(z[1]); oa.z = y[2] * sigmoidf_(a.z + b0.z) * siluf_(z[2]); oa.w = y[3] * sigmoidf_(a.w + b0.w) * siluf_(z[3]);
        ob.x = y[4] * sigmoidf_(b.x + b1.x) * siluf_(z[4]); ob.y = y[5] * sigmoidf_(b.y + b1.y) * siluf_(z[5]); ob.z = y[6] * sigmoidf_(b.z + b1.z) * siluf_(z[6]); ob.w = y[7] * sigmoidf_(b.w + b1.w) * siluf_(z[7]);
        *(uint4*)(mix + (size_t)m * D + n) = pack8(oa, ob);
    }
};
struct EpiOut {
    const float* xr_ctx; const float* xr_lat; const bf16_t* xb_r; bf16_t* xb_w; float* out_lat; const float* mod; int l;
    DEV void vec(int m, int n, const float4& a, const float4& b) const {
        const float* gp = mod + mod_row(m) * 3072 + 2048 + n; const float4 g0 = *(const float4*)gp, g1 = *(const float4*)(gp + 4);
        float xo[8];
        if (l == 0) { const float* xp = m < NCTX ? xr_ctx + (size_t)m * D + n : xr_lat + (size_t)(m - NCTX) * D + n; const float4 x0 = *(const float4*)xp, x1 = *(const float4*)(xp + 4);
            xo[0] = x0.x; xo[1] = x0.y; xo[2] = x0.z; xo[3] = x0.w; xo[4] = x1.x; xo[5] = x1.y; xo[6] = x1.z; xo[7] = x1.w; }
        else unpack8(*(const uint4*)(xb_r + (size_t)m * D + n), xo);
        float4 o0, o1; o0.x = xo[0] + g0.x * a.x; o0.y = xo[1] + g0.y * a.y; o0.z = xo[2] + g0.z * a.z; o0.w = xo[3] + g0.w * a.w;
        o1.x = xo[4] + g1.x * b.x; o1.y = xo[5] + g1.y * b.y; o1.z = xo[6] + g1.z * b.z; o1.w = xo[7] + g1.w * b.w;
        if (l == DEPTH - 1) { float* xw = out_lat + (size_t)(m - NCTX) * D + n; *(float4*)xw = o0; *(float4*)(xw + 4) = o1; }
        else *(uint4*)(xb_w + (size_t)m * D + n) = pack8(o0, o1);
    }
};

DEV void transpose_tile(const float* src, int K, int N, bf16_t* dst, int k0, int n0, float* tile, int tid) {
    const int c = tid & 63, r0 = tid >> 6;
#pragma unroll 4
    for (int i = 0; i < 16; ++i) { const int r = r0 + 4 * i; const int n = n0 + c; tile[r * 65 + c] = (n < N) ? src[(size_t)(k0 + r) * N + n] : 0.f; }
    __syncthreads();
#pragma unroll 4
    for (int i = 0; i < 16; ++i) { const int r = r0 + 4 * i; const int n = n0 + r; if (n < N) dst[(size_t)n * K + k0 + c] = f2bf(tile[c * 65 + r]); }
    __syncthreads();
}

DEV void mod_item(const Params& P, int item, unsigned char* smem, int tid) {
    const int l = item / 48, j0 = (item % 48) * 64;
    float* ssil = (float*)smem;
    float* red = ssil + 5 * 1024;
    for (int i = tid; i < 5 * 1024; i += NTHREADS) { const int r = i >> 10, k = i & 1023; const float cv = r < 4 ? P.in[I_C][r * 1024 + k] : P.in[I_CCTX][k]; ssil[i] = siluf_(cv); }
    __syncthreads();
    const int j = tid & 63, kg = tid >> 6;
    float a0 = 0.f, a1 = 0.f, a2 = 0.f, a3 = 0.f, a4 = 0.f;
    const float* w = P.in[I_WMOD] + (size_t)l * 1024 * 3072 + j0 + j;
#pragma unroll 16
    for (int k = kg * 256; k < kg * 256 + 256; ++k) {
        const float wv = w[(size_t)k * 3072];
        a0 += ssil[k] * wv; a1 += ssil[1024 + k] * wv; a2 += ssil[2048 + k] * wv; a3 += ssil[3072 + k] * wv; a4 += ssil[4096 + k] * wv;
    }
    red[(kg * 5 + 0) * 64 + j] = a0; red[(kg * 5 + 1) * 64 + j] = a1; red[(kg * 5 + 2) * 64 + j] = a2; red[(kg * 5 + 3) * 64 + j] = a3; red[(kg * 5 + 4) * 64 + j] = a4;
    __syncthreads();
    float* mod = (float*)(P.ws + OFF_MOD);
    for (int i = tid; i < 320; i += NTHREADS) {
        const int r = i >> 6, jj = i & 63;
        const float s = red[(0 * 5 + r) * 64 + jj] + red[(1 * 5 + r) * 64 + jj] + red[(2 * 5 + r) * 64 + jj] + red[(3 * 5 + r) * 64 + jj];
        mod[(l * 5 + r) * 3072 + j0 + jj] = s + P.in[I_BMOD][l * 3072 + j0 + jj];
    }
    __syncthreads();
}

DEV void ktab_item(const Params& P, int item, unsigned char* smem, int tid) {
    const int d = item & 1, g = (item >> 1) & 31, l = item >> 6;
    float* sa = (float*)smem; float* srev = sa + 64; float* scr = srev + 64; float* sci = scr + 64;
    float* sBr = sci + 64; float* sBi = sBr + 1024; float* sCr = sBi + 1024; float* sCi = sCr + 1024;
    float* pwr = sCi + 1024; float* pwi = pwr + 2048;
    if (tid < 64) {
        const Disc dc = s5_disc(P, l, d, g, tid);
        sa[tid] = dc.a; srev[tid] = dc.rev; scr[tid] = dc.cr; sci[tid] = dc.ci;
        ((float4*)(P.ws + OFF_DTAB))[((l * 2 + d) * 32 + g) * 64 + tid] = make_float4(dc.a, dc.rev, dc.cr, dc.ci);
        float pr, pi; cpow(dc, 32.f, pr, pi);
        float* lamT = (float*)(P.ws + OFF_LAMT);
        lamT[(((l * 2 + d) * 32 + g) * 64 + tid) * 2 + 0] = pr; lamT[(((l * 2 + d) * 32 + g) * 64 + tid) * 2 + 1] = pi;
    }
    __syncthreads();
#pragma unroll
    for (int i = 0; i < 4; ++i) {
        const int idx = tid + 256 * i, n = idx >> 4;
        const float br = P.in[I_BRE][(size_t)(l * 32 + g) * 1024 + idx], bi = P.in[I_BIM][(size_t)(l * 32 + g) * 1024 + idx];
        sBr[idx] = scr[n] * br - sci[n] * bi; sBi[idx] = scr[n] * bi + sci[n] * br;
        sCr[idx] = P.in[I_CRE][(size_t)(l * 32 + g) * 1024 + idx]; sCi[idx] = P.in[I_CIM][(size_t)(l * 32 + g) * 1024 + idx];
    }
#pragma unroll
    for (int i = 0; i < 8; ++i) {
        const int idx = tid + 256 * i, lag = idx >> 6, n = idx & 63;
        const float e = __expf((float)lag * sa[n]); float s, c; sincos_rev((float)lag * srev[n], s, c);
        pwr[idx] = e * c; pwi[idx] = e * s;
    }
    __syncthreads();
    const int p = tid >> 4, q = tid & 15;
    float* ktab = (float*)(P.ws + OFF_KTAB) + ((size_t)((l * 32 + g) * 2 + d) * 32) * 256;
    for (int lag = 0; lag < 32; ++lag) {
        float acc = 0.f;
#pragma unroll 8
        for (int n = 0; n < 64; ++n) {
            const float cr = sCr[p * 64 + n], ci = sCi[p * 64 + n], pr = pwr[lag * 64 + n], pi = pwi[lag * 64 + n];
            const float zr = cr * pr - ci * pi, zi = cr * pi + ci * pr;
            acc += zr * sBr[n * 16 + q] - zi * sBi[n * 16 + q];
        }
        ktab[lag * 256 + tid] = acc;
    }
    __syncthreads();
}

constexpr int P0_TIN = DEPTH * 16 * 41, P0_TOUT = DEPTH * 16 * 16, P0_TGLU = DEPTH * 8 * 8, P0_MOD = DEPTH * 48, P0_KTAB = DEPTH * 64;
DEV void phase_prep(const Params& P, unsigned char* smem, int tid, int bid, int nb) {
    const int total = P0_TIN + P0_TOUT + P0_TGLU + P0_MOD + P0_KTAB;
    for (int it = bid; it < total; it += nb) {
        int item = it;
        if (item < P0_MOD) { mod_item(P, item, smem, tid); continue; }
        item -= P0_MOD;
        if (item < P0_KTAB) { ktab_item(P, item, smem, tid); continue; }
        item -= P0_KTAB;
        if (item < P0_TIN) { const int l = item / (16 * 41), r = item % (16 * 41);
            transpose_tile(P.in[I_WIN] + (size_t)l * D * INW, D, INW, (bf16_t*)(P.ws + OFF_WIN) + (size_t)l * INW * D, (r / 41) * 64, (r % 41) * 64, (float*)smem, tid); continue; }
        item -= P0_TIN;
        if (item < P0_TOUT) { const int l = item / 256, r = item % 256;
            transpose_tile(P.in[I_WOUT] + (size_t)l * D * D, D, D, (bf16_t*)(P.ws + OFF_WOUT) + (size_t)l * D * D, (r / 16) * 64, (r % 16) * 64, (float*)smem, tid); continue; }
        item -= P0_TOUT;
        { const int l = item / 64, r = item % 64;
            transpose_tile(P.in[I_WGLU] + (size_t)l * 512 * 512, 512, 512, (bf16_t*)(P.ws + OFF_WGLU) + (size_t)l * 512 * 512, (r / 8) * 64, (r % 8) * 64, (float*)smem, tid); }
    }
}

DEV void norm_item(const Params& P, int l, int item, int tid) {
    const int row0 = item * 8 + (tid >> 6) * 2, lane = tid & 63;
    const float* mod = (const float*)(P.ws + OFF_MOD) + (size_t)(l * 5 + mod_row(row0)) * 3072;
    const float* ng = P.in[I_NORMG] + l * 1024;
    bf16_t* ha = (bf16_t*)(P.ws + OFF_HMIX) + (size_t)row0 * D; bf16_t* hb = ha + D;
    float xa[16], xb[16];
    if (l == 0) {
        const float* pa = row0 < NCTX ? P.in[I_CTX] + (size_t)row0 * D : P.in[I_X] + (size_t)(row0 - NCTX) * D; const float* pb = pa + D;
#pragma unroll
        for (int i = 0; i < 2; ++i) {
            const float4 a0 = *(const float4*)(pa + i * 512 + lane * 8), a1 = *(const float4*)(pa + i * 512 + lane * 8 + 4);
            const float4 b0 = *(const float4*)(pb + i * 512 + lane * 8), b1 = *(const float4*)(pb + i * 512 + lane * 8 + 4);
            xa[i * 8] = a0.x; xa[i * 8 + 1] = a0.y; xa[i * 8 + 2] = a0.z; xa[i * 8 + 3] = a0.w; xa[i * 8 + 4] = a1.x; xa[i * 8 + 5] = a1.y; xa[i * 8 + 6] = a1.z; xa[i * 8 + 7] = a1.w;
            xb[i * 8] = b0.x; xb[i * 8 + 1] = b0.y; xb[i * 8 + 2] = b0.z; xb[i * 8 + 3] = b0.w; xb[i * 8 + 4] = b1.x; xb[i * 8 + 5] = b1.y; xb[i * 8 + 6] = b1.z; xb[i * 8 + 7] = b1.w;
        }
    } else {
        const bf16_t* pa = (const bf16_t*)(P.ws + OFF_XB) + (size_t)row0 * D; const bf16_t* pb = pa + D;
#pragma unroll
        for (int i = 0; i < 2; ++i) { unpack8(*(const uint4*)(pa + i * 512 + lane * 8), xa + i * 8); unpack8(*(const uint4*)(pb + i * 512 + lane * 8), xb + i * 8); }
    }
    float sa = 0.f, sb = 0.f;
#pragma unroll
    for (int e = 0; e < 16; ++e) { sa += xa[e] * xa[e]; sb += xb[e] * xb[e]; }
#pragma unroll
    for (int o = 32; o >= 1; o >>= 1) { sa += __shfl_xor(sa, o); sb += __shfl_xor(sb, o); }
    const float ra = rsqrtf(sa * (1.f / 1024.f) + 1e-6f), rb = rsqrtf(sb * (1.f / 1024.f) + 1e-6f);
#pragma unroll
    for (int i = 0; i < 2; ++i) {
        const int c = i * 512 + lane * 8;
        const float4 g0 = *(const float4*)(ng + c), g1 = *(const float4*)(ng + c + 4), h0 = *(const float4*)(mod + c), h1 = *(const float4*)(mod + c + 4);
        const float4 s0 = *(const float4*)(mod + 1024 + c), s1 = *(const float4*)(mod + 1024 + c + 4);
        const float gs[8] = {g0.x * (1.f + s0.x), g0.y * (1.f + s0.y), g0.z * (1.f + s0.z), g0.w * (1.f + s0.w), g1.x * (1.f + s1.x), g1.y * (1.f + s1.y), g1.z * (1.f + s1.z), g1.w * (1.f + s1.w)};
        const float sh[8] = {h0.x, h0.y, h0.z, h0.w, h1.x, h1.y, h1.z, h1.w};
        uint4 oa, ob;
        oa.x = pack2(xa[i * 8] * ra * gs[0] + sh[0], xa[i * 8 + 1] * ra * gs[1] + sh[1]); oa.y = pack2(xa[i * 8 + 2] * ra * gs[2] + sh[2], xa[i * 8 + 3] * ra * gs[3] + sh[3]);
        oa.z = pack2(xa[i * 8 + 4] * ra * gs[4] + sh[4], xa[i * 8 + 5] * ra * gs[5] + sh[5]); oa.w = pack2(xa[i * 8 + 6] * ra * gs[6] + sh[6], xa[i * 8 + 7] * ra * gs[7] + sh[7]);
        ob.x = pack2(xb[i * 8] * rb * gs[0] + sh[0], xb[i * 8 + 1] * rb * gs[1] + sh[1]); ob.y = pack2(xb[i * 8 + 2] * rb * gs[2] + sh[2], xb[i * 8 + 3] * rb * gs[3] + sh[3]);
        ob.z = pack2(xb[i * 8 + 4] * rb * gs[4] + sh[4], xb[i * 8 + 5] * rb * gs[5] + sh[5]); ob.w = pack2(xb[i * 8 + 6] * rb * gs[6] + sh[6], xb[i * 8 + 7] * rb * gs[7] + sh[7]);
        *(uint4*)(ha + c) = oa; *(uint4*)(hb + c) = ob;
    }
}
DEV void expand_my_chunk(const Params& P, int l, size_t e0) {
    const int c0 = (int)(e0 % 768), r = (int)((e0 / 768) % 512), g = (int)(e0 / (768 * 512));
    const int t = r >> 4, p = r & 15;
    float v[8];
    if (c0 < 512) {
        const int s = c0 >> 4, q0 = c0 & 15;
        const float* kt = (const float*)(P.ws + OFF_KTAB) + ((size_t)((l * 32 + g) * 2) * 32) * 256;
        if (t > s) { const float* src = kt + (size_t)(t - s) * 256 + p * 16 + q0;
#pragma unroll
            for (int j = 0; j < 8; ++j) v[j] = src[j];
        } else if (t < s) { const float* src = kt + (size_t)(32 + (s - t)) * 256 + p * 16 + q0;
#pragma unroll
            for (int j = 0; j < 8; ++j) v[j] = src[j];
        } else { const float dsk = P.in[I_SD][l * 512 + g * 16 + p];
#pragma unroll
            for (int j = 0; j < 8; ++j) v[j] = kt[p * 16 + q0 + j] + kt[32 * 256 + p * 16 + q0 + j] + ((q0 + j) == p ? dsk : 0.f);
        }
    } else {
        const int cp = c0 - 512, d = cp >> 7, part = (cp >> 6) & 1, n0 = cp & 63;
        const float k = d == 0 ? (float)(t + 1) : (float)(32 - t);
#pragma unroll
        for (int j = 0; j < 8; ++j) {
            const int n = n0 + j; const Disc dc = s5_disc_tab(P, l, d, g, n); float pr, pi; cpow(dc, k, pr, pi);
            const float cr = P.in[I_CRE][((size_t)(l * 32 + g) * 16 + p) * 64 + n], ci = P.in[I_CIM][((size_t)(l * 32 + g) * 16 + p) * 64 + n];
            v[j] = part == 0 ? (cr * pr - ci * pi) : -(cr * pi + ci * pr);
        }
    }
    uint4 o; o.x = pack2(v[0], v[1]); o.y = pack2(v[2], v[3]); o.z = pack2(v[4], v[5]); o.w = pack2(v[6], v[7]);
    *(uint4*)((bf16_t*)(P.ws + OFF_MY) + e0) = o;
}
DEV void expand_mh_chunk(const Params& P, int l, size_t e0) {
    const int c0 = (int)(e0 % 512), r = (int)((e0 / 512) % 256), g = (int)(e0 / (512 * 256));
    const int d = r >> 7, part = (r >> 6) & 1, n = r & 63, s = c0 >> 4, q0 = c0 & 15;
    const float k = d == 0 ? (float)(31 - s) : (float)s;
    const Disc dc = s5_disc_tab(P, l, d, g, n); float pr, pi; cpow(dc, k, pr, pi);
    const float wr = pr * dc.cr - pi * dc.ci, wi = pr * dc.ci + pi * dc.cr;
    const float* bre = P.in[I_BRE] + ((size_t)(l * 32 + g) * 64 + n) * 16 + q0; const float* bim = P.in[I_BIM] + ((size_t)(l * 32 + g) * 64 + n) * 16 + q0;
    float v[8];
#pragma unroll
    for (int j = 0; j < 8; ++j) v[j] = part == 0 ? (wr * bre[j] - wi * bim[j]) : (wr * bim[j] + wi * bre[j]);
    uint4 o; o.x = pack2(v[0], v[1]); o.y = pack2(v[2], v[3]); o.z = pack2(v[4], v[5]); o.w = pack2(v[6], v[7]);
    *(uint4*)((bf16_t*)(P.ws + OFF_MH) + e0) = o;
}
constexpr int PA_NORM = NTOK / 8, PA_MY = 32 * 512 * 768 / 8192, PA_MH = 32 * 256 * 512 / 8192;
DEV void phase_A(const Params& P, int l, int tid, int bid, int nb) {
    const int total = PA_NORM + PA_MY + PA_MH;
    for (int it = bid; it < total; it += nb) {
        if (it < PA_MY) {
#pragma unroll
            for (int u = 0; u < 4; ++u) expand_my_chunk(P, l, ((size_t)(it * 4 + u) * 256 + tid) * 8);
        } else if (it < PA_MY + PA_MH) {
#pragma unroll
            for (int u = 0; u < 4; ++u) expand_mh_chunk(P, l, ((size_t)((it - PA_MY) * 4 + u) * 256 + tid) * 8);
        } else norm_item(P, l, it - PA_MY - PA_MH, tid);
    }
}

DEV void phase_B(const Params& P, int l, unsigned char* smem, int tid, int bid, int nb) {
    GemmDesc G; G.A = (const bf16_t*)(P.ws + OFF_HMIX); G.lda = D; G.M = NTOK; G.B = (const bf16_t*)(P.ws + OFF_WIN) + (size_t)l * INW * D; G.ldb = D; G.N = INW; G.K = D;
    EpiInProj epi; epi.abuf = (bf16_t*)(P.ws + OFF_ABUF); epi.pbuf = (bf16_t*)(P.ws + OFF_PBUF); epi.lrbuf = (float*)(P.ws + OFF_LR);
    const int total = (NTOK / 128) * 21;
    GR_DECL bool pre = false;
    for (int it = bid; it < total; it += nb) {
        const int j = it >> 3, nx = it + nb, jn = nx >> 3; const bool hn = nx < total;
        gemm_tile(G, ((j / 21) * 8 + (it & 7)) * 128, (j % 21) * 128, epi, GR_ARGS, pre, hn, G, ((jn / 21) * 8 + (nx & 7)) * 128, (jn % 21) * 128, smem, tid); pre = hn;
    }
}

DEV int gla_row(int b, int c, int i) {
    if (c < 4) return b * 256 + c * 64 + i;
    const int cc = c - 4; return NCTX + b * SEQ + ((((cc & 1) * 64) + i) << 6) + (cc >> 1);
}
typedef short s16x4 __attribute__((ext_vector_type(4)));
DEV bf16x8 tr_frag(const bf16_t* img, int stride, int col0, int k0, int lane) {
    const int grp = lane >> 4, li = lane & 15, q = li >> 2, p = li & 3;
    const bf16_t* a = img + (k0 + (grp >> 1) * 8 + q) * stride + col0 + (grp & 1) * 16 + 4 * p;
    const s16x4 lo = __builtin_amdgcn_ds_read_tr16_b64_v4i16((LAS s16x4*)a);
    const s16x4 hi = __builtin_amdgcn_ds_read_tr16_b64_v4i16((LAS s16x4*)(a + 4 * stride));
    bf16x8 r; r[0] = lo[0]; r[1] = lo[1]; r[2] = lo[2]; r[3] = lo[3]; r[4] = hi[0]; r[5] = hi[1]; r[6] = hi[2]; r[7] = hi[3];
    return r;
}
DEV void gla_stage_gate(const Params& P, int l, int b, int c, int d, int h, bf16_t* lrA, bf16_t* wB, int tid) {
    {
        const int i = tid >> 2, r0 = (tid & 3) * 4;
        const float4 x = *(const float4*)((const float*)(P.ws + OFF_LR) + (size_t)gla_row(b, c, i) * 32 + d * 16 + r0);
        const bf16_t h0 = f2bf(x.x), h1 = f2bf(x.y), h2 = f2bf(x.z), h3 = f2bf(x.w);
        uint2 hi, lo; hi.x = (unsigned)h0 | ((unsigned)h1 << 16); hi.y = (unsigned)h2 | ((unsigned)h3 << 16);
        lo.x = pack2(x.x - bf2f(h0), x.y - bf2f(h1)); lo.y = pack2(x.z - bf2f(h2), x.w - bf2f(h3));
        *(uint2*)(lrA + i * 40 + r0) = hi; *(uint2*)(lrA + i * 40 + 16 + r0) = lo;
    }
    {
        const int dk = tid & 63, rq = (tid >> 6) * 4;
#pragma unroll
        for (int u = 0; u < 4; ++u) {
            const float wv = P.in[I_WGATE][(size_t)((l * 2 + d) * 16 + rq + u) * 256 + h * 64 + dk];
            const bf16_t hv = f2bf(wv);
            wB[dk * 40 + rq + u] = hv; wB[dk * 40 + 16 + rq + u] = f2bf(wv - bf2f(hv));
        }
    }
}
DEV void gla_gc_mfma(const Params& P, int l, int d, int h, const bf16_t* lrA, const bf16_t* wB, float* gc, float* tot_s, int tid) {
    const int lane = tid & 63, w = tid >> 6, fr = lane & 31, hh = lane >> 5, fh = hh * 8, mi = w >> 1, nj = w & 1;
    const bf16x8 ahi = *(const bf16x8*)(lrA + (mi * 32 + fr) * 40 + fh), alo = *(const bf16x8*)(lrA + (mi * 32 + fr) * 40 + 16 + fh);
    const bf16x8 bhi = *(const bf16x8*)(wB + (nj * 32 + fr) * 40 + fh), blo = *(const bf16x8*)(wB + (nj * 32 + fr) * 40 + 16 + fh);
    f32x16 z;
#pragma unroll
    for (int r = 0; r < 16; ++r) z[r] = 0.f;
    z = __builtin_amdgcn_mfma_f32_32x32x16_bf16(ahi, bhi, z, 0, 0, 0);
    z = __builtin_amdgcn_mfma_f32_32x32x16_bf16(alo, bhi, z, 0, 0, 0);
    z = __builtin_amdgcn_mfma_f32_32x32x16_bf16(ahi, blo, z, 0, 0, 0);
    const int dk = nj * 32 + fr;
    const float bg = P.in[I_BGATE][(l * 2 + d) * 256 + h * 64 + dk];
    float x[16];
#pragma unroll
    for (int r = 0; r < 16; ++r) { const float zz = fmaxf(z[r] + bg, -80.f); x[r] = __builtin_amdgcn_logf(1.f + __builtin_amdgcn_exp2f(zz * -1.4426950408889634f)) * -0.0625f; }
    float S[4], T[4], base[4];
    if (d == 0) {
#pragma unroll
        for (int g = 0; g < 4; ++g) { x[4 * g + 1] += x[4 * g]; x[4 * g + 2] += x[4 * g + 1]; x[4 * g + 3] += x[4 * g + 2]; S[g] = x[4 * g + 3]; }
    } else {
#pragma unroll
        for (int g = 0; g < 4; ++g) { x[4 * g + 2] += x[4 * g + 3]; x[4 * g + 1] += x[4 * g + 2]; x[4 * g] += x[4 * g + 1]; S[g] = x[4 * g]; }
    }
#pragma unroll
    for (int g = 0; g < 4; ++g) T[g] = __shfl_xor(S[g], 32);
    float run = 0.f;
    if (d == 0) {
#pragma unroll
        for (int g = 0; g < 4; ++g) { base[g] = run + (hh ? T[g] : 0.f); run += S[g] + T[g]; }
    } else {
#pragma unroll
        for (int g = 3; g >= 0; --g) { base[g] = run + (hh ? 0.f : T[g]); run += S[g] + T[g]; }
    }
    if (hh == 0) tot_s[mi * 64 + dk] = run;
    __syncthreads();
    const float off = d == 0 ? (mi == 1 ? tot_s[dk] : 0.f) : (mi == 0 ? tot_s[64 + dk] : 0.f);
#pragma unroll
    for (int g = 0; g < 4; ++g)
#pragma unroll
        for (int j = 0; j < 4; ++j) gc[(mi * 32 + 8 * g + 4 * hh + j) * 64 + dk] = x[4 * g + j] + base[g] + off;
    __syncthreads();
}
DEV void gla_load_v(const Params& P, int b, int c, int h, bf16_t* Vs, int tid) {
    const int i = tid >> 2, dv0 = (tid & 3) * 32;
    const bf16_t* src = (const bf16_t*)(P.ws + OFF_PBUF) + (size_t)gla_row(b, c, i) * PW + 1024 + h * 128 + dv0;
#pragma unroll
    for (int u = 0; u < 4; ++u) *(uint4*)(Vs + i * 160 + dv0 + u * 8) = *(const uint4*)(src + u * 8);
}

#define GLP_PARAMS float4& p_lr, float4& p_w, uint4& p_v0, uint4& p_v1, uint4& p_v2, uint4& p_v3, uint4& p_k0, uint4& p_k1
DEV void gla_local_load(const Params& P, int l, int item, int tid, GLP_PARAMS) {
    const int d = item & 1, c = (item >> 1) % NCH, bh = (item >> 1) / NCH, h = bh & 3, b = bh >> 2;
    { const int i = tid >> 2, r0 = (tid & 3) * 4; p_lr = *(const float4*)((const float*)(P.ws + OFF_LR) + (size_t)gla_row(b, c, i) * 32 + d * 16 + r0); }
    { const int dk = tid & 63, rq = (tid >> 6) * 4; const float* wp = P.in[I_WGATE] + (size_t)((l * 2 + d) * 16 + rq) * 256 + h * 64 + dk;
      p_w.x = wp[0]; p_w.y = wp[256]; p_w.z = wp[512]; p_w.w = wp[768]; }
    { const int i = tid >> 2, dv0 = (tid & 3) * 32; const bf16_t* src = (const bf16_t*)(P.ws + OFF_PBUF) + (size_t)gla_row(b, c, i) * PW + 1024 + h * 128 + dv0;
      p_v0 = *(const uint4*)(src); p_v1 = *(const uint4*)(src + 8); p_v2 = *(const uint4*)(src + 16); p_v3 = *(const uint4*)(src + 24); }
    { const int kj = tid >> 2, dk0 = (tid & 3) * 16; const bf16_t* ksrc = (const bf16_t*)(P.ws + OFF_PBUF) + (size_t)gla_row(b, c, kj) * PW + 768 + h * 64 + dk0;
      p_k0 = *(const uint4*)(ksrc); p_k1 = *(const uint4*)(ksrc + 8); }
}
DEV void gla_stage_gate_regs(const float4& x, const float4& wv4, bf16_t* lrA, bf16_t* wB, int tid) {
    {
        const int i = tid >> 2, r0 = (tid & 3) * 4;
        const bf16_t h0 = f2bf(x.x), h1 = f2bf(x.y), h2 = f2bf(x.z), h3 = f2bf(x.w);
        uint2 hi, lo; hi.x = (unsigned)h0 | ((unsigned)h1 << 16); hi.y = (unsigned)h2 | ((unsigned)h3 << 16);
        lo.x = pack2(x.x - bf2f(h0), x.y - bf2f(h1)); lo.y = pack2(x.z - bf2f(h2), x.w - bf2f(h3));
        *(uint2*)(lrA + i * 40 + r0) = hi; *(uint2*)(lrA + i * 40 + 16 + r0) = lo;
    }
    {
        const int dk = tid & 63, rq = (tid >> 6) * 4;
        const float wv[4] = {wv4.x, wv4.y, wv4.z, wv4.w};
#pragma unroll
        for (int u = 0; u < 4; ++u) { const bf16_t hv = f2bf(wv[u]); wB[dk * 40 + rq + u] = hv; wB[dk * 40 + 16 + rq + u] = f2bf(wv[u] - bf2f(hv)); }
    }
}
DEV void gla_local_item(const Params& P, int l, int item, unsigned char* smem, int tid, const float4& p_lr, const float4& p_w, const uint4& p_v0, const uint4& p_v1, const uint4& p_v2, const uint4& p_v3, const uint4& w0, const uint4& w1) {
    const int d = item & 1, c = (item >> 1) % NCH, bh = (item >> 1) / NCH, h = bh & 3, b = bh >> 2;
    float* gc = (float*)smem; bf16_t* kd = (bf16_t*)(smem + 16384); bf16_t* Vs = (bf16_t*)(smem + 28672);
    bf16_t* lrA = (bf16_t*)(smem + 49152); bf16_t* wB = (bf16_t*)(smem + 54272); float* tot_s = (float*)(smem + 59392);
    gla_stage_gate_regs(p_lr, p_w, lrA, wB, tid);
    { const int i = tid >> 2, dv0 = (tid & 3) * 32; bf16_t* dst = Vs + i * 160 + dv0; *(uint4*)(dst) = p_v0; *(uint4*)(dst + 8) = p_v1; *(uint4*)(dst + 16) = p_v2; *(uint4*)(dst + 24) = p_v3; }
    const int chain = (b * 4 + h) * 2 + d;
    const int kj = tid >> 2, dk0 = (tid & 3) * 16;
    __syncthreads();
    gla_gc_mfma(P, l, d, h, lrA, wB, gc, tot_s, tid);
    {
        const unsigned ww[8] = {w0.x, w0.y, w0.z, w0.w, w1.x, w1.y, w1.z, w1.w};
        const float* gtot = gc + (d == 0 ? 63 * 64 : 0);
        unsigned ko[8];
#pragma unroll
        for (int e = 0; e < 8; ++e) {
            const int dk = dk0 + 2 * e;
            const float k0 = __uint_as_float(ww[e] << 16), k1 = __uint_as_float(ww[e] & 0xffff0000u);
            ko[e] = pack2(k0 * __builtin_amdgcn_exp2f(gtot[dk] - gc[kj * 64 + dk]), k1 * __builtin_amdgcn_exp2f(gtot[dk + 1] - gc[kj * 64 + dk + 1]));
        }
        *(uint4*)(kd + kj * 96 + dk0) = make_uint4(ko[0], ko[1], ko[2], ko[3]); *(uint4*)(kd + kj * 96 + dk0 + 8) = make_uint4(ko[4], ko[5], ko[6], ko[7]);
        if (tid < 64) ((float*)(P.ws + OFF_DEC))[(size_t)(chain * NCH + c) * 64 + tid] = __builtin_amdgcn_exp2f(gtot[tid]);
    }
    __syncthreads();
    const int lane = tid & 63, w = tid >> 6, fr = lane & 31, hh = lane >> 5;
    f32x16 acc[2];
#pragma unroll
    for (int nj = 0; nj < 2; ++nj)
#pragma unroll
        for (int r = 0; r < 16; ++r) acc[nj][r] = 0.f;
#pragma unroll
    for (int ks = 0; ks < 4; ++ks) {
        const bf16x8 bv = tr_frag(Vs, 160, w * 32, ks * 16, lane);
        const bf16x8 a0 = tr_frag(kd, 96, 0, ks * 16, lane), a1 = tr_frag(kd, 96, 32, ks * 16, lane);
        acc[0] = __builtin_amdgcn_mfma_f32_32x32x16_bf16(a0, bv, acc[0], 0, 0, 0);
        acc[1] = __builtin_amdgcn_mfma_f32_32x32x16_bf16(a1, bv, acc[1], 0, 0, 0);
    }
    bf16_t* ds = (bf16_t*)(P.ws + OFF_DS) + (size_t)(chain * NCH + c) * 8192 + (w * 32 + fr) * 64;
#pragma unroll
    for (int nj = 0; nj < 2; ++nj)
#pragma unroll
        for (int g = 0; g < 4; ++g) {
            uint2 o; o.x = pack2(acc[nj][4 * g], acc[nj][4 * g + 1]); o.y = pack2(acc[nj][4 * g + 2], acc[nj][4 * g + 3]);
            *(uint2*)(ds + nj * 32 + 8 * g + 4 * hh) = o;
        }
    __syncthreads();
}
constexpr int PC_S5 = 32 * 9 * 2, PC_GLA = NB * 4 * NCH * 2;
DEV void phase_C(const Params& P, int l, unsigned char* smem, int tid_, int bid, int nb) {
    const int tid_in = tid_;
    {
        float4 a_lr, a_w, b_lr, b_w; uint4 a_v0, a_v1, a_v2, a_v3, a_k0, a_k1, b_v0, b_v1, b_v2, b_v3, b_k0, b_k1;
        a_lr = a_w = b_lr = b_w = make_float4(0.f, 0.f, 0.f, 0.f); a_v0 = a_v1 = a_v2 = a_v3 = a_k0 = a_k1 = b_v0 = b_v1 = b_v2 = b_v3 = b_k0 = b_k1 = make_uint4(0u, 0u, 0u, 0u);
        int it = bid;
        if (it < PC_GLA) gla_local_load(P, l, it, tid_in, a_lr, a_w, a_v0, a_v1, a_v2, a_v3, a_k0, a_k1);
        while (it < PC_GLA) {
            { int tid = tid_in; asm volatile("" : "+v"(tid));
              const int nx = it + nb; if (nx < PC_GLA) gla_local_load(P, l, nx, tid, b_lr, b_w, b_v0, b_v1, b_v2, b_v3, b_k0, b_k1);
              gla_local_item(P, l, it, smem, tid, a_lr, a_w, a_v0, a_v1, a_v2, a_v3, a_k0, a_k1); it = nx; }
            if (it >= PC_GLA) break;
            { int tid = tid_in; asm volatile("" : "+v"(tid));
              const int nx = it + nb; if (nx < PC_GLA) gla_local_load(P, l, nx, tid, a_lr, a_w, a_v0, a_v1, a_v2, a_v3, a_k0, a_k1);
              gla_local_item(P, l, it, smem, tid, b_lr, b_w, b_v0, b_v1, b_v2, b_v3, b_k0, b_k1); it = nx; }
        }
    }
    int tid = tid_in; asm volatile("" : "+v"(tid));
    GR_DECL bool pre = false;
    auto mk = [&](int item, GemmDesc& G, EpiHloc& epi, int& m0, int& n0) {
        const int j = item >> 3, g = (j / 18) * 8 + (item & 7), mt = (j % 18) >> 1, nt = j & 1;
        G.A = (const bf16_t*)(P.ws + OFF_ABUF) + (size_t)g * NSUB * 768; G.lda = 768; G.M = NSUB;
        G.B = (const bf16_t*)(P.ws + OFF_MH) + (size_t)g * 256 * 512; G.ldb = 512; G.N = 256; G.K = 512;
        epi.hloc = (float*)(P.ws + OFF_HY) + (size_t)g * NSUB * 256; m0 = mt * 128; n0 = nt * 128;
    };
    for (int item = nb - 1 - bid; item < PC_S5; item += nb) {
        GemmDesc G, Gn; EpiHloc epi, epin; int m0, n0, m0n, n0n; const int nx = item + nb; const bool hn = nx < PC_S5;
        mk(item, G, epi, m0, n0); mk(hn ? nx : item, Gn, epin, m0n, n0n);
        gemm_tile(G, m0, n0, epi, GR_ARGS, pre, hn, Gn, m0n, n0n, smem, tid); pre = hn;
    }
}

DEV void s5_scan_item(const Params& P, int l, int item, int tid) {
    const int idx = item * 256 + tid, n = idx & 63, d = (idx >> 6) & 1, g = (idx >> 7) & 31, b = idx >> 12;
    const float* lamT = (const float*)(P.ws + OFF_LAMT) + (size_t)(((l * 2 + d) * 32 + g) * 64 + n) * 2;
    const float ltr = lamT[0], lti = lamT[1];
    const float* __restrict__ hloc = (const float*)(P.ws + OFF_HY) + (size_t)g * NSUB * 256 + d * 128 + n;
    bf16_t* __restrict__ hin = (bf16_t*)(P.ws + OFF_ABUF) + (size_t)g * NSUB * 768 + 512 + d * 128 + n;
    float hr = 0.f, hi = 0.f;
    for (int s0 = 0; s0 < 264; s0 += 24) {
        float lr_[24], li_[24]; int sub[24];
#pragma unroll
        for (int u = 0; u < 24; ++u) {
            const int step = s0 + u;
            sub[u] = step < 8 ? b * 8 + (d == 0 ? step : 7 - step) : 32 + b * 256 + (d == 0 ? step - 8 : 263 - step);
            lr_[u] = hloc[(size_t)sub[u] * 256]; li_[u] = hloc[(size_t)sub[u] * 256 + 64];
        }
#pragma unroll
        for (int u = 0; u < 24; ++u) {
            hin[(size_t)sub[u] * 768] = f2bf(hr); hin[(size_t)sub[u] * 768 + 64] = f2bf(hi);
            const float nr = ltr * hr - lti * hi + lr_[u], ni = ltr * hi + lti * hr + li_[u];
            hr = nr; hi = ni;
        }
    }
}
DEV int gla_chain_chunk(int d, int step) { return d == 0 ? step : (step < 4 ? 3 - step : 135 - step); }
DEV void gla_scan_item(const Params& P, int item, int tid) {
    const int chain = item >> 4, e2 = (item & 15) * 256 + tid, dk = (e2 * 2) & 63, d = chain & 1;
    unsigned* ds = (unsigned*)(P.ws + OFF_DS) + (size_t)chain * NCH * 4096 + e2;
    const float* dec = (const float*)(P.ws + OFF_DEC) + (size_t)chain * NCH * 64 + dk;
    float s0 = 0.f, s1 = 0.f;
    for (int st = 0; st < NCH; st += 12) {
        unsigned t[12]; float2 dc[12]; int c[12];
#pragma unroll
        for (int u = 0; u < 12; ++u) { c[u] = gla_chain_chunk(d, st + u); t[u] = ds[(size_t)c[u] * 4096]; dc[u] = *(const float2*)(dec + c[u] * 64); }
#pragma unroll
        for (int u = 0; u < 12; ++u) {
            ds[(size_t)c[u] * 4096] = pack2(s0, s1);
            s0 = dc[u].x * s0 + __uint_as_float(t[u] << 16); s1 = dc[u].y * s1 + __uint_as_float(t[u] & 0xffff0000u);
        }
    }
}
constexpr int PD_S5 = 64, PD_GLA = 32 * 16;
DEV void phase_D(const Params& P, int l, int tid, int bid, int nb) {
    const int total = PD_S5 + PD_GLA;
    for (int it = bid; it < total; it += nb) { if (it < PD_S5) s5_scan_item(P, l, it, tid); else gla_scan_item(P, it - PD_S5, tid); }
}

DEV void gla_out_item(const Params& P, int l, int item, unsigned char* smem, int tid) {
    const int c = item % NCH, bh = item / NCH, h = bh & 3, b = bh >> 2;
    float* gc = (float*)smem; bf16_t* qt = (bf16_t*)(smem + 16384); bf16_t* kt = (bf16_t*)(smem + 25600); bf16_t* Pm = (bf16_t*)(smem + 34816);
    bf16_t* Vs = (bf16_t*)(smem + 44032); bf16_t* lrA = (bf16_t*)(smem + 64512); bf16_t* wB = (bf16_t*)(smem + 69632); float* tot_s = (float*)(smem + 74752);
    float* o_s = (float*)smem;
    const int lane = tid & 63, w = tid >> 6, fr = lane & 31, hh = lane >> 5, fh = hh * 8;
    f32x16 acco[2];
#pragma unroll
    for (int mi = 0; mi < 2; ++mi)
#pragma unroll
        for (int r = 0; r < 16; ++r) acco[mi][r] = 0.f;
    gla_load_v(P, b, c, h, Vs, tid);
    for (int d = 0; d < 2; ++d) {
        const int chain = (b * 4 + h) * 2 + d;
        gla_stage_gate(P, l, b, c, d, h, lrA, wB, tid);
        const bf16_t* sp = (const bf16_t*)(P.ws + OFF_DS) + (size_t)(chain * NCH + c) * 8192 + (w * 32 + fr) * 64 + fh;
        bf16x8 sf[4];
#pragma unroll
        for (int ks = 0; ks < 4; ++ks) sf[ks] = *(const bf16x8*)(sp + ks * 16);
        const int qi = tid >> 2, dk0 = (tid & 3) * 16;
        const bf16_t* qsrc = (const bf16_t*)(P.ws + OFF_PBUF) + (size_t)gla_row(b, c, qi) * PW + 512 + h * 64 + dk0;
        const uint4 q0 = *(const uint4*)(qsrc), q1 = *(const uint4*)(qsrc + 8), k0 = *(const uint4*)(qsrc + 256), k1 = *(const uint4*)(qsrc + 264);
        __syncthreads();
        gla_gc_mfma(P, l, d, h, lrA, wB, gc, tot_s, tid);
        {
            const unsigned qq[8] = {q0.x, q0.y, q0.z, q0.w, q1.x, q1.y, q1.z, q1.w}, kk[8] = {k0.x, k0.y, k0.z, k0.w, k1.x, k1.y, k1.z, k1.w};
            unsigned qo[8], ko[8];
#pragma unroll
            for (int e = 0; e < 8; ++e) {
                const float g0 = gc[qi * 64 + dk0 + 2 * e], g1 = gc[qi * 64 + dk0 + 2 * e + 1];
                const float e0 = __builtin_amdgcn_exp2f(g0), e1 = __builtin_amdgcn_exp2f(g1), n0 = __builtin_amdgcn_exp2f(-g0), n1 = __builtin_amdgcn_exp2f(-g1);
                qo[e] = pack2(__uint_as_float(qq[e] << 16) * 0.125f * e0, __uint_as_float(qq[e] & 0xffff0000u) * 0.125f * e1);
                ko[e] = pack2(__uint_as_float(kk[e] << 16) * n0, __uint_as_float(kk[e] & 0xffff0000u) * n1);
            }
            *(uint4*)(qt + qi * 72 + dk0) = make_uint4(qo[0], qo[1], qo[2], qo[3]); *(uint4*)(qt + qi * 72 + dk0 + 8) = make_uint4(qo[4], qo[5], qo[6], qo[7]);
            *(uint4*)(kt + qi * 72 + dk0) = make_uint4(ko[0], ko[1], ko[2], ko[3]); *(uint4*)(kt + qi * 72 + dk0 + 8) = make_uint4(ko[4], ko[5], ko[6], ko[7]);
        }
        __syncthreads();
        {
            const int mj = w >> 1, ni = w & 1;
            f32x16 sc;
#pragma unroll
            for (int r = 0; r < 16; ++r) sc[r] = 0.f;
#pragma unroll
            for (int ks = 0; ks < 4; ++ks) {
                const bf16x8 a = *(const bf16x8*)(kt + (mj * 32 + fr) * 72 + ks * 16 + fh), bb = *(const bf16x8*)(qt + (ni * 32 + fr) * 72 + ks * 16 + fh);
                sc = __builtin_amdgcn_mfma_f32_32x32x16_bf16(a, bb, sc, 0, 0, 0);
            }
            const int i = ni * 32 + fr;
#pragma unroll
            for (int g = 0; g < 4; ++g) {
                const int j0 = mj * 32 + 8 * g + 4 * hh;
                float v[4];
#pragma unroll
                for (int jj = 0; jj < 4; ++jj) { const bool keep = d == 0 ? (j0 + jj <= i) : (j0 + jj >= i); v[jj] = keep ? sc[4 * g + jj] : 0.f; }
                uint2 o; o.x = pack2(v[0], v[1]); o.y = pack2(v[2], v[3]);
                *(uint2*)(Pm + i * 72 + j0) = o;
            }
        }
        __syncthreads();
#pragma unroll
        for (int ks = 0; ks < 4; ++ks) {
            const bf16x8 bv = tr_frag(Vs, 160, w * 32, ks * 16, lane);
            const bf16x8 bs = sf[ks];
            const bf16x8 p0 = *(const bf16x8*)(Pm + fr * 72 + ks * 16 + fh), p1 = *(const bf16x8*)(Pm + (32 + fr) * 72 + ks * 16 + fh);
            const bf16x8 a0 = *(const bf16x8*)(qt + fr * 72 + ks * 16 + fh), a1 = *(const bf16x8*)(qt + (32 + fr) * 72 + ks * 16 + fh);
            acco[0] = __builtin_amdgcn_mfma_f32_32x32x16_bf16(p0, bv, acco[0], 0, 0, 0);
            acco[1] = __builtin_amdgcn_mfma_f32_32x32x16_bf16(p1, bv, acco[1], 0, 0, 0);
            acco[0] = __builtin_amdgcn_mfma_f32_32x32x16_bf16(a0, bs, acco[0], 0, 0, 0);
            acco[1] = __builtin_amdgcn_mfma_f32_32x32x16_bf16(a1, bs, acco[1], 0, 0, 0);
        }
        __syncthreads();
    }
#pragma unroll
    for (int mi = 0; mi < 2; ++mi)
#pragma unroll
        for (int r = 0; r < 16; ++r) { const int i = mi * 32 + (r & 3) + 8 * (r >> 2) + 4 * (lane >> 5); o_s[i * 132 + w * 32 + fr] = acco[mi][r]; }
    __syncthreads();
    {
        const int i = tid >> 2, dv0 = (tid & 3) * 32;
        float ov[32]; float ss = 0.f;
#pragma unroll
        for (int u = 0; u < 8; ++u) { const float4 f = *(const float4*)(o_s + i * 132 + dv0 + u * 4); ov[u * 4] = f.x; ov[u * 4 + 1] = f.y; ov[u * 4 + 2] = f.z; ov[u * 4 + 3] = f.w;
            ss += f.x * f.x + f.y * f.y + f.z * f.z + f.w * f.w; }
        ss += __shfl_xor(ss, 1); ss += __shfl_xor(ss, 2);
        const float rstd = rsqrtf(ss * (1.f / 128.f) + 1e-6f);
        const int row = gla_row(b, c, i);
        const bf16_t* zg = (const bf16_t*)(P.ws + OFF_PBUF) + (size_t)row * PW + 1536 + h * 128 + dv0;
        const float* gn = P.in[I_GNORM] + l * 128 + dv0;
        bf16_t* mo = (bf16_t*)(P.ws + OFF_HMIX) + (size_t)row * D + 512 + h * 128 + dv0;
#pragma unroll
        for (int u = 0; u < 4; ++u) {
            const uint4 z = *(const uint4*)(zg + u * 8); const unsigned zz[4] = {z.x, z.y, z.z, z.w}; unsigned oo[4];
#pragma unroll
            for (int e = 0; e < 4; ++e) {
                const float z0 = __uint_as_float(zz[e] << 16), z1 = __uint_as_float(zz[e] & 0xffff0000u);
                oo[e] = pack2(ov[u * 8 + 2 * e] * rstd * gn[u * 8 + 2 * e] * siluf_(z0), ov[u * 8 + 2 * e + 1] * rstd * gn[u * 8 + 2 * e + 1] * siluf_(z1));
            }
            *(uint4*)(mo + u * 8) = make_uint4(oo[0], oo[1], oo[2], oo[3]);
        }
    }
    __syncthreads();
}
constexpr int PE_S5 = 32 * 9 * 4, PE_GLA = NB * 4 * NCH;
DEV void phase_E(const Params& P, int l, unsigned char* smem, int tid_, int bid, int nb) {
    const int tid_in = tid_;
    for (int it = bid; it < PE_GLA; it += nb) { int tid = tid_in; asm volatile("" : "+v"(tid)); gla_out_item(P, l, it, smem, tid); }
    int tid = tid_in; asm volatile("" : "+v"(tid));
    GR_DECL bool pre = false;
    auto mk = [&](int item, GemmDesc& G, EpiS5Out& epi, int& m0, int& n0) {
        const int j = item >> 3, g = (j / 36) * 8 + (item & 7), mt = (j % 36) >> 2, nt = j & 3;
        G.A = (const bf16_t*)(P.ws + OFF_ABUF) + (size_t)g * NSUB * 768; G.lda = 768; G.M = NSUB;
        G.B = (const bf16_t*)(P.ws + OFF_MY) + (size_t)g * 512 * 768; G.ldb = 768; G.N = 512; G.K = 768;
        epi.ybuf = (bf16_t*)(P.ws + OFF_HY); epi.g = g; m0 = mt * 128; n0 = nt * 128;
    };
    for (int item = nb - 1 - bid; item < PE_S5; item += nb) {
        GemmDesc G, Gn; EpiS5Out epi, epin; int m0, n0, m0n, n0n; const int nx = item + nb; const bool hn = nx < PE_S5;
        mk(item, G, epi, m0, n0); mk(hn ? nx : item, Gn, epin, m0n, n0n);
        gemm_tile(G, m0, n0, epi, GR_ARGS, pre, hn, Gn, m0n, n0n, smem, tid); pre = hn;
    }
}

DEV void phase_F(const Params& P, int l, unsigned char* smem, int tid, int bid, int nb) {
    GemmDesc G; G.A = (const bf16_t*)(P.ws + OFF_HY); G.lda = 512; G.M = NTOK; G.B = (const bf16_t*)(P.ws + OFF_WGLU) + (size_t)l * 512 * 512; G.ldb = 512; G.N = 512; G.K = 512;
    EpiGlu epi; epi.ybuf = (const bf16_t*)(P.ws + OFF_HY); epi.pbuf = (const bf16_t*)(P.ws + OFF_PBUF); epi.bglu = P.in[I_BGLU] + l * 512; epi.mix = (bf16_t*)(P.ws + OFF_HMIX);
    const int total = (NTOK / 128) * 4;
    GR_DECL bool pre = false;
    for (int it = bid + (l == DEPTH - 1 ? 32 : 0); it < total; it += nb) {
        const int j = it >> 3, nx = it + nb, jn = nx >> 3; const bool hn = nx < total;
        gemm_tile(G, ((j >> 2) * 8 + (it & 7)) * 128, (j & 3) * 128, epi, GR_ARGS, pre, hn, G, ((jn >> 2) * 8 + (nx & 7)) * 128, (jn & 3) * 128, smem, tid); pre = hn;
    }
}
DEV void phase_G(const Params& P, int l, unsigned char* smem, int tid, int bid, int nb) {
    GemmDesc G; G.A = (const bf16_t*)(P.ws + OFF_HMIX); G.lda = D; G.M = NTOK; G.B = (const bf16_t*)(P.ws + OFF_WOUT) + (size_t)l * D * D; G.ldb = D; G.N = D; G.K = D;
    EpiOut epi; epi.mod = (const float*)(P.ws + OFF_MOD) + (size_t)l * 5 * 3072; epi.l = l;
    epi.xr_ctx = P.in[I_CTX]; epi.xr_lat = P.in[I_X]; epi.xb_r = (const bf16_t*)(P.ws + OFF_XB); epi.xb_w = (bf16_t*)(P.ws + OFF_XB); epi.out_lat = P.out;
    const int total = (NTOK / 128) * 8;
    GR_DECL bool pre = false;
    for (int it = bid + (l == DEPTH - 1 ? 64 : 0); it < total; it += nb) {
        const int j = it >> 3, nx = it + nb, jn = nx >> 3; const bool hn = nx < total;
        gemm_tile(G, ((j >> 3) * 8 + (it & 7)) * 128, (j & 7) * 128, epi, GR_ARGS, pre, hn, G, ((jn >> 3) * 8 + (nx & 7)) * 128, (jn & 7) * 128, smem, tid); pre = hn;
    }
}
DEV void phase_final(const Params& P, int tid, int bid, int nb) {
    const int total = NB * SEQ / 4;
    for (int it = bid; it < total; it += nb) {
        const int row = it * 4 + (tid >> 6), lane = tid & 63;
        float* x = P.out + (size_t)row * D;
        float4 v[4]; float ss = 0.f;
#pragma unroll
        for (int i = 0; i < 4; ++i) { v[i] = *(const float4*)(x + (i * 64 + lane) * 4); ss += v[i].x * v[i].x + v[i].y * v[i].y + v[i].z * v[i].z + v[i].w * v[i].w; }
#pragma unroll
        for (int o = 32; o >= 1; o >>= 1) ss += __shfl_xor(ss, o);
        const float rstd = rsqrtf(ss * (1.f / 1024.f) + 1e-6f);
#pragma unroll
        for (int i = 0; i < 4; ++i) {
            const int c = (i * 64 + lane) * 4; const float4 g = *(const float4*)(P.in[I_FNORM] + c);
            float4 o; o.x = v[i].x * rstd * g.x; o.y = v[i].y * rstd * g.y; o.z = v[i].z * rstd * g.z; o.w = v[i].w * rstd * g.w;
            *(float4*)(x + c) = o;
        }
    }
}


#define XB_TMO      128
#define XB_XCNT(j)  (256  + 64 * (j))
#define XB_XSUB(j)  (1280 + 64 * (j))
#define XB_XGEN(j)  (2304 + 64 * (j))
#define XB_TOP      3328
#define XB_TOPGEN   3392
#define XCD_BAR_WORDS 3456
#define XB_SPIN_CAP (1u << 20)
DEV unsigned xb_ld(unsigned* p)              { return __hip_atomic_load(p, __ATOMIC_RELAXED, __HIP_MEMORY_SCOPE_AGENT); }
DEV unsigned xb_add(unsigned* p, unsigned v) { return __hip_atomic_fetch_add(p, v, __ATOMIC_RELAXED, __HIP_MEMORY_SCOPE_AGENT); }
DEV unsigned xb_xcc_id() { return (unsigned)__builtin_amdgcn_s_getreg((3 << 11) | 20) & 0xFu; }
#define XB_SPIN(cond, bar) do { unsigned _sp = 0; while (cond) { __builtin_amdgcn_s_sleep(1); \
    if ((++_sp & 255u) == 0u) { if (xb_ld(&(bar)[XB_TMO])) break; if (_sp > XB_SPIN_CAP) { atomicAdd(&(bar)[XB_TMO], 1u); break; } } } } while (0)
struct XcdBarrier { unsigned* bar; unsigned x; volatile LAS unsigned* st; };
DEV XcdBarrier xcd_barrier_post(unsigned* bar, volatile LAS unsigned* st) {
    XcdBarrier b; b.bar = bar; b.x = xb_xcc_id(); b.st = st;
    if (threadIdx.x == 0) (void)xb_add(&bar[XB_XCNT(b.x)], 1u);
    return b;
}
DEV void xcd_barrier_complete(unsigned* bar, unsigned x, unsigned& nloc, unsigned& nx) {
    const unsigned G = gridDim.x * gridDim.y * gridDim.z;
    unsigned sum, cnt, mine, sp = 0u;
    for (;;) {
        sum = 0u; cnt = 0u; mine = 0u;
#pragma unroll
        for (unsigned j = 0; j < 16; ++j) { const unsigned c = xb_ld(&bar[XB_XCNT(j)]); sum += c; cnt += (c > 0u) ? 1u : 0u; mine = (j == x) ? c : mine; }
        if (sum == G) break;
        __builtin_amdgcn_s_sleep(1);
        if ((++sp & 255u) == 0u) { if (xb_ld(&bar[XB_TMO])) break; if (sp > XB_SPIN_CAP) { atomicAdd(&bar[XB_TMO], 1u); break; } }
    }
    nloc = mine > 0u ? mine : 1u; nx = cnt > 0u ? cnt : 1u;
}
DEV void xcd_barrier(const XcdBarrier& b) {
    asm volatile("s_waitcnt vmcnt(0)" ::: "memory");
    __syncthreads();
    if (threadIdx.x == 0) {
        unsigned* bar = b.bar;
        __builtin_amdgcn_s_waitcnt(0);
        unsigned nloc = b.st[0], nx = b.st[1];
        if (nloc == 0u) { xcd_barrier_complete(bar, b.x, nloc, nx); b.st[0] = nloc; b.st[1] = nx; }
        const unsigned old = xb_add(&bar[XB_XSUB(b.x)], 1u);
        const unsigned gen = old / nloc;
        if (old + 1u == (gen + 1u) * nloc) {
            __builtin_amdgcn_fence(__ATOMIC_RELEASE, "agent");
            asm volatile("s_waitcnt vmcnt(0)" ::: "memory");
            const unsigned og = xb_add(&bar[XB_TOP], 1u);
            const unsigned tg = og / nx;
            if (og + 1u == (tg + 1u) * nx) xb_add(&bar[XB_TOPGEN], 1u);
            else XB_SPIN(xb_ld(&bar[XB_TOPGEN]) == tg, bar);
            __builtin_amdgcn_fence(__ATOMIC_ACQUIRE, "agent");
            xb_add(&bar[XB_XGEN(b.x)], 1u);
            asm volatile("s_waitcnt vmcnt(0)" ::: "memory");
        } else {
            XB_SPIN(xb_ld(&bar[XB_XGEN(b.x)]) == gen, bar);
            __builtin_amdgcn_fence(__ATOMIC_ACQUIRE, "agent");
            asm volatile("s_waitcnt vmcnt(0)" ::: "memory");
        }
    }
    __syncthreads();
}

__global__ void __launch_bounds__(NTHREADS, 2) fwd_megakernel(Params P, int ph_lo, int ph_hi) {
    extern __shared__ __attribute__((aligned(16))) unsigned char smem[];
    cg::grid_group grid = cg::this_grid();
    const int tid0 = threadIdx.x, bid0 = blockIdx.x, nb0 = gridDim.x;
    volatile LAS unsigned* xst = (volatile LAS unsigned*)(smem + LDS_MAIN);
    if (tid0 < 4) xst[tid0] = 0u;
    __syncthreads();
    const XcdBarrier xb = xcd_barrier_post((unsigned*)(P.ws + OFF_BAR), xst);
    for (int ph = ph_lo; ph < ph_hi; ++ph) {
        int tid = tid0, bid = bid0, nb = nb0;
        asm volatile("" : "+v"(tid)); asm volatile("" : "+s"(bid)); asm volatile("" : "+s"(nb));
        if (ph == 0) { if (PHMASK & 1) { phase_prep(P, smem, tid, bid, nb); if (REPP0) { asm volatile("" : "+v"(tid)); phase_prep(P, smem, tid, bid, nb); } } }
        else if (ph == NPHASE - 1) { if (PHMASK & 256) phase_final(P, tid, bid, nb); }
        else {
            const int l = (ph - 1) / 7, s = (ph - 1) % 7;
            for (int rep = 0; rep < (((REPMASK >> s) & 1) ? 2 : 1); ++rep) {
            asm volatile("" : "+v"(tid)); asm volatile("" : "+s"(bid)); asm volatile("" : "+s"(nb));
            switch (s) {
                case 0: if (PHMASK & 2) phase_A(P, l, tid, bid, nb); break;
                case 1: if (PHMASK & 4) phase_B(P, l, smem, tid, bid, nb); break;
                case 2: if (PHMASK & 8) phase_C(P, l, smem, tid, bid, nb); break;
                case 3: if (PHMASK & 16) phase_D(P, l, tid, bid, nb); break;
                case 4: if (PHMASK & 32) phase_E(P, l, smem, tid, bid, nb); break;
                case 5: if (PHMASK & 64) phase_F(P, l, smem, tid, bid, nb); break;
                default: if (PHMASK & 128) { phase_G(P, l, smem, tid, bid, nb); if (REPG0 && l == 0) phase_G(P, l, smem, tid, bid, nb); } break;
            }
            }
        }
        if (ph + 1 < ph_hi) { if (ph_hi > 4096) grid.sync(); xcd_barrier(xb); }
    }
}

extern "C" void kernel_launch(void* const* d_in, const int* in_sizes, int n_in, void* d_out, int out_size, void* d_ws, size_t ws_size, hipStream_t stream) {
    static int grid_blocks = 0;
    if (grid_blocks == 0) {
        if (n_in != 23 || ws_size < WS_END) { fprintf(stderr, "kernel_launch: unexpected n_in %d or ws_size %zu (< %zu)\n", n_in, ws_size, (size_t)WS_END); grid_blocks = -1; return; }
        int dev = 0, cus = 0, per_cu = 0;
        hipGetDevice(&dev);
        hipDeviceGetAttribute(&cus, hipDeviceAttributeMultiprocessorCount, dev);
        if (hipFuncSetAttribute((const void*)fwd_megakernel, hipFuncAttributeMaxDynamicSharedMemorySize, LDS_BYTES) != hipSuccess) { fprintf(stderr, "kernel_launch: hipFuncSetAttribute failed\n"); grid_blocks = -1; return; }
        if (hipOccupancyMaxActiveBlocksPerMultiprocessor(&per_cu, (const void*)fwd_megakernel, NTHREADS, LDS_BYTES) != hipSuccess || per_cu < 1) { fprintf(stderr, "kernel_launch: occupancy query failed (%d)\n", per_cu); grid_blocks = -1; return; }
        if (per_cu > 2) per_cu = 2;
        grid_blocks = cus * per_cu;
    }
    if (grid_blocks < 0) return;
    Params p{};
    for (int i = 0; i < 23; ++i) p.in[i] = (const float*)d_in[i];
    p.out = (float*)d_out; p.ws = (unsigned char*)d_ws;
    (void)hipMemsetAsync((unsigned char*)d_ws + OFF_BAR, 0, 3456 * 4, stream);
#if MULTI_LAUNCH
    for (int ph = 0; ph < NPHASE; ++ph) hipLaunchKernelGGL(fwd_megakernel, dim3(grid_blocks), dim3(NTHREADS), LDS_BYTES, stream, p, ph, ph + 1);
#else
    int lo = 0, hi = NPHASE;
    void* args[] = {&p, &lo, &hi};
    hipError_t e = hipLaunchCooperativeKernel((const void*)fwd_megakernel, dim3(grid_blocks), dim3(NTHREADS), args, LDS_BYTES, stream);
    if (e != hipSuccess) fprintf(stderr, "cooperative launch failed: %s (grid %d)\n", hipGetErrorString(e), grid_blocks);
#endif
}
```

```cpp
#include <hip/hip_runtime.h>
#include <hip/hip_cooperative_groups.h>
#include <cstdio>
#include <cstdint>
namespace cg = cooperative_groups;

typedef unsigned short bf16_t;
typedef short bf16x8 __attribute__((ext_vector_type(8)));
typedef float f32x16 __attribute__((ext_vector_type(16)));

#define DEV __device__ __forceinline__
#define LAS __attribute__((address_space(3)))

#ifndef PHMASK
#define PHMASK 0x1ff
#endif
#ifndef REPMASK
#define REPMASK 0
#endif
#ifndef SYNCX
#define SYNCX 0
#endif
#ifndef REPG0
#define REPG0 0
#endif
#ifndef REPD
#define REPD 0
#endif
#ifndef REPP0
#define REPP0 0
#endif
#ifndef EPI_UNROLL
#define EPI_UNROLL 4
#endif
#ifndef MULTI_LAUNCH
#define MULTI_LAUNCH 0
#endif

constexpr int D = 1024, NB = 4, SEQ = 8192, DEPTH = 4, CTXL = 256;
constexpr int NCTX = NB * CTXL;
constexpr int NTOK = NCTX + NB * SEQ;
constexpr int INW = 2592, PW = 2080;
constexpr int NSUB = NTOK / 32;
constexpr int NCH = 132;
constexpr int NTHREADS = 256;
constexpr int LDS_MAIN = 75264;
constexpr int LDS_BYTES = LDS_MAIN + 16;
constexpr int NPHASE = 2 + 7 * DEPTH;

constexpr size_t OFF_XCTX = 0;
constexpr size_t OFF_HMIX = OFF_XCTX + (size_t)NCTX * D * 4;
constexpr size_t OFF_PBUF = OFF_HMIX + (size_t)NTOK * D * 2;
constexpr size_t OFF_ABUF = OFF_PBUF + (size_t)NTOK * PW * 2;
constexpr size_t OFF_HY   = OFF_ABUF + (size_t)32 * NSUB * 768 * 2;
constexpr size_t OFF_DS   = OFF_HY + (size_t)32 * NSUB * 256 * 4;
constexpr size_t OFF_XB   = OFF_DS + (size_t)32 * NCH * 8192 * 2;
constexpr size_t OFF_DEC  = OFF_DS + (size_t)32 * NCH * 8192 * 4;
constexpr size_t OFF_WIN  = OFF_DEC + (size_t)32 * NCH * 64 * 4;
constexpr size_t OFF_WOUT = OFF_WIN + (size_t)DEPTH * INW * D * 2;
constexpr size_t OFF_WGLU = OFF_WOUT + (size_t)DEPTH * D * D * 2;
constexpr size_t OFF_MY   = OFF_WGLU + (size_t)DEPTH * 512 * 512 * 2;
constexpr size_t OFF_MH   = OFF_MY + (size_t)32 * 512 * 768 * 2;
constexpr size_t OFF_KTAB = OFF_MH + (size_t)32 * 256 * 512 * 2;
constexpr size_t OFF_LR   = OFF_KTAB + (size_t)DEPTH * 32 * 2 * 32 * 256 * 4;
constexpr size_t OFF_MOD  = OFF_LR + (size_t)NTOK * 32 * 4;
constexpr size_t OFF_LAMT = OFF_MOD + (size_t)DEPTH * 5 * 3072 * 4;
constexpr size_t OFF_BAR  = OFF_LAMT + (size_t)DEPTH * 2 * 32 * 64 * 2 * 4;
constexpr size_t OFF_DTAB = OFF_BAR + 3456 * 4 + 256;
constexpr size_t WS_END   = OFF_DTAB + (size_t)DEPTH * 2 * 32 * 64 * 16;

struct Params {
    const float* in[23];
    float* out;
    unsigned char* ws;
};
enum { I_X = 0, I_C, I_CTX, I_CCTX, I_NORMG, I_WMOD, I_BMOD, I_WIN, I_LAMRE, I_LAMIM, I_LOGDT, I_BRE, I_BIM, I_CRE, I_CIM, I_SD, I_WGLU, I_BGLU,
       I_WGATE, I_BGATE, I_GNORM, I_WOUT, I_FNORM };

DEV bf16_t f2bf(float f) { const __bf16 h = (__bf16)f; return __builtin_bit_cast(bf16_t, h); }
DEV float bf2f(bf16_t h) { return __uint_as_float(((unsigned)h) << 16); }
typedef float f32x2_t __attribute__((ext_vector_type(2)));
typedef __bf16 bf16x2_t __attribute__((ext_vector_type(2)));
DEV unsigned pack2(float a, float b) { const f32x2_t v = {a, b}; const bf16x2_t h = __builtin_convertvector(v, bf16x2_t); return __builtin_bit_cast(unsigned, h); }
DEV float sigmoidf_(float x) { return 1.f / (1.f + __expf(-x)); }
DEV float siluf_(float x) { return x * sigmoidf_(x); }
DEV float gelu_tanh(float x) { float u = 0.7978845608028654f * (x + 0.044715f * x * x * x); return x * sigmoidf_(2.f * u); }
DEV void sincos_rev(float rev, float& s, float& c) { float f = rev - floorf(rev); s = __builtin_amdgcn_sinf(f); c = __builtin_amdgcn_cosf(f); }

struct Disc { float a, rev, cr, ci; };
DEV Disc s5_disc(const Params& P, int l, int d, int g, int n) {
    const int idx = ((l * 2 + d) * 32 + g) * 64 + n;
    const float lr = P.in[I_LAMRE][idx], li = P.in[I_LAMIM][idx];
    const float dt = expf(P.in[I_LOGDT][(l * 2 + d) * 32 + g]);
    Disc o; o.a = lr * dt; const float w = li * dt; o.rev = w * 0.15915494309189535f;
    float s, c, sh, ch; sincos_rev(o.rev, s, c); sincos_rev(0.5f * o.rev, sh, ch);
    const float em1 = expm1f(o.a);
    const float br = em1 * c - 2.f * sh * sh, bi = (em1 + 1.f) * s;
    const float den = lr * lr + li * li;
    o.cr = (br * lr + bi * li) / den; o.ci = (bi * lr - br * li) / den;
    return o;
}
DEV Disc s5_disc_tab(const Params& P, int l, int d, int g, int n) {
    const float4 t = ((const float4*)(P.ws + OFF_DTAB))[((l * 2 + d) * 32 + g) * 64 + n];
    Disc o; o.a = t.x; o.rev = t.y; o.cr = t.z; o.ci = t.w; return o;
}
DEV void cpow(const Disc& dc, float k, float& pr, float& pi) { const float e = __expf(k * dc.a); float s, c; sincos_rev(k * dc.rev, s, c); pr = e * c; pi = e * s; }

DEV const float* xrow_c(const Params& P, int l, int row) {
    if (l == 0) return row < NCTX ? P.in[I_CTX] + (size_t)row * D : P.in[I_X] + (size_t)(row - NCTX) * D;
    return row < NCTX ? (const float*)(P.ws + OFF_XCTX) + (size_t)row * D : P.out + (size_t)(row - NCTX) * D;
}
DEV float* xrow_w(const Params& P, int row) { return row < NCTX ? (float*)(P.ws + OFF_XCTX) + (size_t)row * D : P.out + (size_t)(row - NCTX) * D; }
DEV int mod_row(int row) { return row < NCTX ? 4 : ((row - NCTX) >> 13); }

struct GemmDesc { const bf16_t* A; size_t lda; int M; const bf16_t* B; size_t ldb; int N; int K; };

#define GR_PARAMS uint4& r0a0, uint4& r0a1, uint4& r0a2, uint4& r0a3, uint4& r0b0, uint4& r0b1, uint4& r0b2, uint4& r0b3, uint4& r1a0, uint4& r1a1, uint4& r1a2, uint4& r1a3, uint4& r1b0, uint4& r1b1, uint4& r1b2, uint4& r1b3, uint4& r2a0, uint4& r2a1, uint4& r2a2, uint4& r2a3, uint4& r2b0, uint4& r2b1, uint4& r2b2, uint4& r2b3
#define GR_ARGS r0a0, r0a1, r0a2, r0a3, r0b0, r0b1, r0b2, r0b3, r1a0, r1a1, r1a2, r1a3, r1b0, r1b1, r1b2, r1b3, r2a0, r2a1, r2a2, r2a3, r2b0, r2b1, r2b2, r2b3
#define GR_DECL uint4 r0a0 = make_uint4(0u, 0u, 0u, 0u), r0a1 = make_uint4(0u, 0u, 0u, 0u), r0a2 = make_uint4(0u, 0u, 0u, 0u), r0a3 = make_uint4(0u, 0u, 0u, 0u), r0b0 = make_uint4(0u, 0u, 0u, 0u), r0b1 = make_uint4(0u, 0u, 0u, 0u), r0b2 = make_uint4(0u, 0u, 0u, 0u), r0b3 = make_uint4(0u, 0u, 0u, 0u), r1a0 = make_uint4(0u, 0u, 0u, 0u), r1a1 = make_uint4(0u, 0u, 0u, 0u), r1a2 = make_uint4(0u, 0u, 0u, 0u), r1a3 = make_uint4(0u, 0u, 0u, 0u), r1b0 = make_uint4(0u, 0u, 0u, 0u), r1b1 = make_uint4(0u, 0u, 0u, 0u), r1b2 = make_uint4(0u, 0u, 0u, 0u), r1b3 = make_uint4(0u, 0u, 0u, 0u), r2a0 = make_uint4(0u, 0u, 0u, 0u), r2a1 = make_uint4(0u, 0u, 0u, 0u), r2a2 = make_uint4(0u, 0u, 0u, 0u), r2a3 = make_uint4(0u, 0u, 0u, 0u), r2b0 = make_uint4(0u, 0u, 0u, 0u), r2b1 = make_uint4(0u, 0u, 0u, 0u), r2b2 = make_uint4(0u, 0u, 0u, 0u), r2b3 = make_uint4(0u, 0u, 0u, 0u);
template <class Epi>
DEV void gemm_tile(const GemmDesc& G, int m0, int n0, const Epi& epi, GR_PARAMS, bool preloaded, bool has_next, const GemmDesc& Gn, int m0n, int n0n, unsigned char* smem, int tid) {
    bf16_t* sA = (bf16_t*)smem;
    bf16_t* sB = sA + 2 * 128 * 72;
    const int lane = tid & 63, wave = tid >> 6, wm = wave >> 1, wn = wave & 1;
    const int lr = tid >> 3, kc = (tid & 7) * 8;
    const bf16_t* Abase = G.A + ((size_t)(m0 + lr) * G.lda + kc); const bf16_t* Bbase = G.B + ((size_t)(n0 + lr) * G.ldb + kc);
    const unsigned sa32 = 32u * (unsigned)G.lda, sb32 = 32u * (unsigned)G.ldb;
    f32x16 acc[2][2];
#pragma unroll
    for (int i = 0; i < 2; ++i)
#pragma unroll
        for (int j = 0; j < 2; ++j)
#pragma unroll
            for (int r = 0; r < 16; ++r) acc[i][j][r] = 0.f;
    const int nk = G.K >> 6;
    const int fr = lane & 31, fh = (lane >> 5) * 8;
#define G_LOAD(RA, RB, KT) { G_LOADH0(RA, RB, KT) G_LOADH1(RA, RB, KT) }
#define G_LOADH0(RA, RB, KT) { unsigned sa_ = sa32, sb_ = sb32; asm volatile("" : "+s"(sa_)); asm volatile("" : "+s"(sb_)); \
        const bf16_t* pa_ = Abase + (KT) * 64; const bf16_t* pb_ = Bbase + (KT) * 64; \
        RA##0 = *(const uint4*)(pa_); RB##0 = *(const uint4*)(pb_); RA##1 = *(const uint4*)(pa_ + sa_); RB##1 = *(const uint4*)(pb_ + sb_); }
#define G_LOADH1(RA, RB, KT) { unsigned sa_ = sa32, sb_ = sb32; asm volatile("" : "+s"(sa_)); asm volatile("" : "+s"(sb_)); \
        const bf16_t* pa_ = Abase + (KT) * 64; const bf16_t* pb_ = Bbase + (KT) * 64; \
        RA##2 = *(const uint4*)(pa_ + 2 * sa_); RB##2 = *(const uint4*)(pb_ + 2 * sb_); RA##3 = *(const uint4*)(pa_ + 3 * sa_); RB##3 = *(const uint4*)(pb_ + 3 * sb_); }
#define G_STORE(RA, RB, BUF) { G_STOREH0(RA, RB, BUF) G_STOREH1(RA, RB, BUF) }
#define G_STOREH0(RA, RB, BUF) { bf16_t* dA = sA + (BUF) * (128 * 72); bf16_t* dB = sB + (BUF) * (128 * 72); \
        *(uint4*)(dA + (lr) * 72 + kc) = RA##0; *(uint4*)(dB + (lr) * 72 + kc) = RB##0; *(uint4*)(dA + (lr + 32) * 72 + kc) = RA##1; *(uint4*)(dB + (lr + 32) * 72 + kc) = RB##1; }
#define G_STOREH1(RA, RB, BUF) { bf16_t* dA = sA + (BUF) * (128 * 72); bf16_t* dB = sB + (BUF) * (128 * 72); \
        *(uint4*)(dA + (lr + 64) * 72 + kc) = RA##2; *(uint4*)(dB + (lr + 64) * 72 + kc) = RB##2; *(uint4*)(dA + (lr + 96) * 72 + kc) = RA##3; *(uint4*)(dB + (lr + 96) * 72 + kc) = RB##3; }
#define G_LDA0(KS) { fa0 = *(const bf16x8*)(cA + (KS) * 16); }
#define G_LDA1(KS) { fa1 = *(const bf16x8*)(cA + 32 * 72 + (KS) * 16); }
#define G_LDB(KS, B0, B1) { B0 = *(const bf16x8*)(cB + (KS) * 16); B1 = *(const bf16x8*)(cB + 32 * 72 + (KS) * 16); }
#define G_MM0(B0, B1) { acc[0][0] = __builtin_amdgcn_mfma_f32_32x32x16_bf16(B0, fa0, acc[0][0], 0, 0, 0); acc[0][1] = __builtin_amdgcn_mfma_f32_32x32x16_bf16(B1, fa0, acc[0][1], 0, 0, 0); }
#define G_MM1(B0, B1) { acc[1][0] = __builtin_amdgcn_mfma_f32_32x32x16_bf16(B0, fa1, acc[1][0], 0, 0, 0); acc[1][1] = __builtin_amdgcn_mfma_f32_32x32x16_bf16(B1, fa1, acc[1][1], 0, 0, 0); }
#define G_SB __builtin_amdgcn_sched_barrier(0);
#define G_STEP(RA, RB, KT) { \
        const bf16_t* cA = sA + ((KT) & 1) * (128 * 72) + (wm * 64 + fr) * 72 + fh; \
        const bf16_t* cB = sB + ((KT) & 1) * (128 * 72) + (wn * 64 + fr) * 72 + fh; \
        bf16x8 fa0, fa1, xb0, xb1, yb0, yb1; \
        G_LDA0(0) G_LDB(0, xb0, xb1) G_LDA1(0) G_LDB(1, yb0, yb1) G_SB \
        G_MM0(xb0, xb1) G_SB G_LDA0(1) G_SB G_MM1(xb0, xb1) G_SB G_LDA1(1) G_LDB(2, xb0, xb1) G_SB \
        if ((KT) + 1 < nk) G_STOREH0(RA, RB, ((KT) + 1) & 1) \
        if ((KT) + 4 < nk) G_LOADH0(RA, RB, (KT) + 4) \
        G_SB G_MM0(yb0, yb1) G_SB G_LDA0(2) G_SB G_MM1(yb0, yb1) G_SB G_LDA1(2) G_LDB(3, yb0, yb1) G_SB \
        if ((KT) + 1 < nk) G_STOREH1(RA, RB, ((KT) + 1) & 1) \
        if ((KT) + 4 < nk) G_LOADH1(RA, RB, (KT) + 4) \
        G_SB G_MM0(xb0, xb1) G_SB G_LDA0(3) G_SB G_MM1(xb0, xb1) G_SB G_LDA1(3) G_SB \
        G_MM0(yb0, yb1) G_MM1(yb0, yb1) G_SB \
        __syncthreads(); }
    if (!preloaded) { G_LOAD(r0a, r0b, 0) G_LOAD(r1a, r1b, 1) G_LOAD(r2a, r2b, 2) }
    G_STORE(r0a, r0b, 0)
    __syncthreads();
    G_LOAD(r0a, r0b, 3)
    for (int kt = 0; kt < nk; kt += 3) {
        G_STEP(r1a, r1b, kt)
        if (kt + 1 < nk) G_STEP(r2a, r2b, kt + 1)
        if (kt + 2 < nk) G_STEP(r0a, r0b, kt + 2)
    }
    if (has_next) {
        const bf16_t* Abase = Gn.A + ((size_t)(m0n + lr) * Gn.lda + kc); const bf16_t* Bbase = Gn.B + ((size_t)(n0n + lr) * Gn.ldb + kc);
        const unsigned sa32 = 32u * (unsigned)Gn.lda, sb32 = 32u * (unsigned)Gn.ldb;
        G_LOAD(r0a, r0b, 0) G_LOAD(r1a, r1b, 1) G_LOAD(r2a, r2b, 2)
    }
#undef G_LOAD
#undef G_STORE
#undef G_STEP
#undef G_LDA0
#undef G_LDA1
#undef G_LDB
#undef G_MM0
#undef G_MM1
#undef G_LOADH0
#undef G_LOADH1
#undef G_STOREH0
#undef G_STOREH1
#undef G_SB
    float* sC = (float*)smem;
    int te = tid; asm volatile("" : "+v"(te));
    const int lane_e = te & 63, wave_e = te >> 6, wm_e = wave_e >> 1, wn_e = wave_e & 1, fr_e = lane_e & 31;
#pragma unroll
    for (int i = 0; i < 2; ++i)
#pragma unroll
        for (int j = 0; j < 2; ++j)
#pragma unroll
            for (int g = 0; g < 4; ++g) {
                float4 v; v.x = acc[i][j][4 * g]; v.y = acc[i][j][4 * g + 1]; v.z = acc[i][j][4 * g + 2]; v.w = acc[i][j][4 * g + 3];
                *(float4*)(sC + (wm_e * 64 + i * 32 + fr_e) * 132 + wn_e * 64 + j * 32 + 8 * g + 4 * (lane_e >> 5)) = v;
            }
    __syncthreads();
#pragma unroll EPI_UNROLL
    for (int u = 0; u < 8; ++u) {
        const int c = te + 256 * u, ml = c >> 4, n8 = (c & 15) * 8;
        const float4 v0 = *(const float4*)(sC + ml * 132 + n8), v1 = *(const float4*)(sC + ml * 132 + n8 + 4);
        if (m0 + ml < G.M && n0 + n8 < G.N) epi.vec(m0 + ml, n0 + n8, v0, v1);
    }
    __syncthreads();
}

DEV uint4 pack8(const float4& a, const float4& b) { uint4 o; o.x = pack2(a.x, a.y); o.y = pack2(a.z, a.w); o.z = pack2(b.x, b.y); o.w = pack2(b.z, b.w); return o; }
DEV void unpack8(const uint4& w, float* f) {
    f[0] = __uint_as_float(w.x << 16); f[1] = __uint_as_float(w.x & 0xffff0000u); f[2] = __uint_as_float(w.y << 16); f[3] = __uint_as_float(w.y & 0xffff0000u);
    f[4] = __uint_as_float(w.z << 16); f[5] = __uint_as_float(w.z & 0xffff0000u); f[6] = __uint_as_float(w.w << 16); f[7] = __uint_as_float(w.w & 0xffff0000u);
}
struct EpiInProj {
    bf16_t* abuf; bf16_t* pbuf; float* lrbuf;
    DEV void vec(int m, int n, const float4& a, const float4& b) const {
        const uint4 o = pack8(a, b);
        if (n < 512) *(uint4*)(abuf + ((size_t)(n >> 4) * NSUB + (m >> 5)) * 768 + (m & 31) * 16 + (n & 15)) = o;
        else { *(uint4*)(pbuf + (size_t)m * PW + (n - 512)) = o;
            if (n >= 2560) { *(float4*)(lrbuf + (size_t)m * 32 + (n - 2560)) = a; *(float4*)(lrbuf + (size_t)m * 32 + (n - 2560) + 4) = b; } }
    }
};
struct EpiHloc {
    float* hloc;
    DEV void vec(int m, int n, const float4& a, const float4& b) const { *(float4*)(hloc + (size_t)m * 256 + n) = a; *(float4*)(hloc + (size_t)m * 256 + n + 4) = b; }
};
struct EpiS5Out {
    bf16_t* ybuf; int g;
    DEV void vec(int m, int n, const float4& a, const float4& b) const {
        float4 ga, gb; ga.x = gelu_tanh(a.x); ga.y = gelu_tanh(a.y); ga.z = gelu_tanh(a.z); ga.w = gelu_tanh(a.w); gb.x = gelu_tanh(b.x); gb.y = gelu_tanh(b.y); gb.z = gelu_tanh(b.z); gb.w = gelu_tanh(b.w);
        *(uint4*)(ybuf + ((size_t)m * 32 + (n >> 4)) * 512 + g * 16 + (n & 15)) = pack8(ga, gb);
    }
};
struct EpiGlu {
    const bf16_t* ybuf; const bf16_t* pbuf; const float* bglu; bf16_t* mix;
    DEV void vec(int m, int n, const float4& a, const float4& b) const {
        float y[8], z[8]; unpack8(*(const uint4*)(ybuf + (size_t)m * 512 + n), y); unpack8(*(const uint4*)(pbuf + (size_t)m * PW + n), z);
        const float4 b0 = *(const float4*)(bglu + n), b1 = *(const float4*)(bglu + n + 4);
        float4 oa, ob;
        oa.x = y[0] * sigmoidf_(a.x + b0.x) * siluf_(z[0]); oa.y = y[1] * sigmoidf_(a.y + b0.y) * siluf_(z[1]); oa.z = y[2] * sigmoidf_(a.z + b0.z) * siluf_(z[2]); oa.w = y[3] * sigmoidf_(a.w + b0.w) * siluf_(z[3]);
        ob.x = y[4] * sigmoidf_(b.x + b1.x) * siluf_(z[4]); ob.y = y[5] * sigmoidf_(b.y + b1.y) * siluf_(z[5]); ob.z = y[6] * sigmoidf_(b.z + b1.z) * siluf_(z[6]); ob.w = y[7] * sigmoidf_(b.w + b1.w) * siluf_(z[7]);
        *(uint4*)(mix + (size_t)m * D + n) = pack8(oa, ob);
    }
};
struct EpiOut {
    const float* xr_ctx; const float* xr_lat; const bf16_t* xb_r; bf16_t* xb_w; float* out_lat; const float* mod; int l;
    DEV void vec(int m, int n, const float4& a, const float4& b) const {
        const float* gp = mod + mod_row(m) * 3072 + 2048 + n; const float4 g0 = *(const float4*)gp, g1 = *(const float4*)(gp + 4);
        float xo[8];
        if (l == 0) { const float* xp = m < NCTX ? xr_ctx + (size_t)m * D + n : xr_lat + (size_t)(m - NCTX) * D + n; const float4 x0 = *(const float4*)xp, x1 = *(const float4*)(xp + 4);
            xo[0] = x0.x; xo[1] = x0.y; xo[2] = x0.z; xo[3] = x0.w; xo[4] = x1.x; xo[5] = x1.y; xo[6] = x1.z; xo[7] = x1.w; }
        else unpack8(*(const uint4*)(xb_r + (size_t)m * D + n), xo);
        float4 o0, o1; o0.x = xo[0] + g0.x * a.x; o0.y = xo[1] + g0.y * a.y; o0.z = xo[2] + g0.z * a.z; o0.w = xo[3] + g0.w * a.w;
        o1.x = xo[4] + g1.x * b.x; o1.y = xo[5] + g1.y * b.y; o1.z = xo[6] + g1.z * b.z; o1.w = xo[7] + g1.w * b.w;
        if (l == DEPTH - 1) { float* xw = out_lat + (size_t)(m - NCTX) * D + n; *(float4*)xw = o0; *(float4*)(xw + 4) = o1; }
        else *(uint4*)(xb_w + (size_t)m * D + n) = pack8(o0, o1);
    }
};

DEV void transpose_tile(const float* src, int K, int N, bf16_t* dst, int k0, int n0, float* tile, int tid) {
    const int c = tid & 63, r0 = tid >> 6;
#pragma unroll 4
    for (int i = 0; i < 16; ++i) { const int r = r0 + 4 * i; const int n = n0 + c; tile[r * 65 + c] = (n < N) ? src[(size_t)(k0 + r) * N + n] : 0.f; }
    __syncthreads();
#pragma unroll 4
    for (int i = 0; i < 16; ++i) { const int r = r0 + 4 * i; const int n = n0 + r; if (n < N) dst[(size_t)n * K + k0 + c] = f2bf(tile[c * 65 + r]); }
    __syncthreads();
}

DEV void mod_item(const Params& P, int item, unsigned char* smem, int tid) {
    const int l = item / 48, j0 = (item % 48) * 64;
    float* ssil = (float*)smem;
    float* red = ssil + 5 * 1024;
    for (int i = tid; i < 5 * 1024; i += NTHREADS) { const int r = i >> 10, k = i & 1023; const float cv = r < 4 ? P.in[I_C][r * 1024 + k] : P.in[I_CCTX][k]; ssil[i] = siluf_(cv); }
    __syncthreads();
    const int j = tid & 63, kg = tid >> 6;
    float a0 = 0.f, a1 = 0.f, a2 = 0.f, a3 = 0.f, a4 = 0.f;
    const float* w = P.in[I_WMOD] + (size_t)l * 1024 * 3072 + j0 + j;
#pragma unroll 16
    for (int k = kg * 256; k < kg * 256 + 256; ++k) {
        const float wv = w[(size_t)k * 3072];
        a0 += ssil[k] * wv; a1 += ssil[1024 + k] * wv; a2 += ssil[2048 + k] * wv; a3 += ssil[3072 + k] * wv; a4 += ssil[4096 + k] * wv;
    }
    red[(kg * 5 + 0) * 64 + j] = a0; red[(kg * 5 + 1) * 64 + j] = a1; red[(kg * 5 + 2) * 64 + j] = a2; red[(kg * 5 + 3) * 64 + j] = a3; red[(kg * 5 + 4) * 64 + j] = a4;
    __syncthreads();
    float* mod = (float*)(P.ws + OFF_MOD);
    for (int i = tid; i < 320; i += NTHREADS) {
        const int r = i >> 6, jj = i & 63;
        const float s = red[(0 * 5 + r) * 64 + jj] + red[(1 * 5 + r) * 64 + jj] + red[(2 * 5 + r) * 64 + jj] + red[(3 * 5 + r) * 64 + jj];
        mod[(l * 5 + r) * 3072 + j0 + jj] = s + P.in[I_BMOD][l * 3072 + j0 + jj];
    }
    __syncthreads();
}

DEV void ktab_item(const Params& P, int item, unsigned char* smem, int tid) {
    const int d = item & 1, g = (item >> 1) & 31, l = item >> 6;
    float* sa = (float*)smem; float* srev = sa + 64; float* scr = srev + 64; float* sci = scr + 64;
    float* sBr = sci + 64; float* sBi = sBr + 1024; float* sCr = sBi + 1024; float* sCi = sCr + 1024;
    float* pwr = sCi + 1024; float* pwi = pwr + 2048;
    if (tid < 64) {
        const Disc dc = s5_disc(P, l, d, g, tid);
        sa[tid] = dc.a; srev[tid] = dc.rev; scr[tid] = dc.cr; sci[tid] = dc.ci;
        ((float4*)(P.ws + OFF_DTAB))[((l * 2 + d) * 32 + g) * 64 + tid] = make_float4(dc.a, dc.rev, dc.cr, dc.ci);
        float pr, pi; cpow(dc, 32.f, pr, pi);
        float* lamT = (float*)(P.ws + OFF_LAMT);
        lamT[(((l * 2 + d) * 32 + g) * 64 + tid) * 2 + 0] = pr; lamT[(((l * 2 + d) * 32 + g) * 64 + tid) * 2 + 1] = pi;
    }
    __syncthreads();
#pragma unroll
    for (int i = 0; i < 4; ++i) {
        const int idx = tid + 256 * i, n = idx >> 4;
        const float br = P.in[I_BRE][(size_t)(l * 32 + g) * 1024 + idx], bi = P.in[I_BIM][(size_t)(l * 32 + g) * 1024 + idx];
        sBr[idx] = scr[n] * br - sci[n] * bi; sBi[idx] = scr[n] * bi + sci[n] * br;
        sCr[idx] = P.in[I_CRE][(size_t)(l * 32 + g) * 1024 + idx]; sCi[idx] = P.in[I_CIM][(size_t)(l * 32 + g) * 1024 + idx];
    }
#pragma unroll
    for (int i = 0; i < 8; ++i) {
        const int idx = tid + 256 * i, lag = idx >> 6, n = idx & 63;
        const float e = __expf((float)lag * sa[n]); float s, c; sincos_rev((float)lag * srev[n], s, c);
        pwr[idx] = e * c; pwi[idx] = e * s;
    }
    __syncthreads();
    const int p = tid >> 4, q = tid & 15;
    float* ktab = (float*)(P.ws + OFF_KTAB) + ((size_t)((l * 32 + g) * 2 + d) * 32) * 256;
    for (int lag = 0; lag < 32; ++lag) {
        float acc = 0.f;
#pragma unroll 8
        for (int n = 0; n < 64; ++n) {
            const float cr = sCr[p * 64 + n], ci = sCi[p * 64 + n], pr = pwr[lag * 64 + n], pi = pwi[lag * 64 + n];
            const float zr = cr * pr - ci * pi, zi = cr * pi + ci * pr;
            acc += zr * sBr[n * 16 + q] - zi * sBi[n * 16 + q];
        }
        ktab[lag * 256 + tid] = acc;
    }
    __syncthreads();
}

constexpr int P0_TIN = DEPTH * 16 * 41, P0_TOUT = DEPTH * 16 * 16, P0_TGLU = DEPTH * 8 * 8, P0_MOD = DEPTH * 48, P0_KTAB = DEPTH * 64;
DEV void phase_prep(const Params& P, unsigned char* smem, int tid, int bid, int nb) {
    const int total = P0_TIN + P0_TOUT + P0_TGLU + P0_MOD + P0_KTAB;
    for (int it = bid; it < total; it += nb) {
        int item = it;
        if (item < P0_MOD) { mod_item(P, item, smem, tid); continue; }
        item -= P0_MOD;
        if (item < P0_KTAB) { ktab_item(P, item, smem, tid); continue; }
        item -= P0_KTAB;
        if (item < P0_TIN) { const int l = item / (16 * 41), r = item % (16 * 41);
            transpose_tile(P.in[I_WIN] + (size_t)l * D * INW, D, INW, (bf16_t*)(P.ws + OFF_WIN) + (size_t)l * INW * D, (r / 41) * 64, (r % 41) * 64, (float*)smem, tid); continue; }
        item -= P0_TIN;
        if (item < P0_TOUT) { const int l = item / 256, r = item % 256;
            transpose_tile(P.in[I_WOUT] + (size_t)l * D * D, D, D, (bf16_t*)(P.ws + OFF_WOUT) + (size_t)l * D * D, (r / 16) * 64, (r % 16) * 64, (float*)smem, tid); continue; }
        item -= P0_TOUT;
        { const int l = item / 64, r = item % 64;
            transpose_tile(P.in[I_WGLU] + (size_t)l * 512 * 512, 512, 512, (bf16_t*)(P.ws + OFF_WGLU) + (size_t)l * 512 * 512, (r / 8) * 64, (r % 8) * 64, (float*)smem, tid); }
    }
}

DEV void norm_item(const Params& P, int l, int item, int tid) {
    const int row0 = item * 8 + (tid >> 6) * 2, lane = tid & 63;
    const float* mod = (const float*)(P.ws + OFF_MOD) + (size_t)(l * 5 + mod_row(row0)) * 3072;
    const float* ng = P.in[I_NORMG] + l * 1024;
    bf16_t* ha = (bf16_t*)(P.ws + OFF_HMIX) + (size_t)row0 * D; bf16_t* hb = ha + D;
    float xa[16], xb[16];
    if (l == 0) {
        const float* pa = row0 < NCTX ? P.in[I_CTX] + (size_t)row0 * D : P.in[I_X] + (size_t)(row0 - NCTX) * D; const float* pb = pa + D;
#pragma unroll
        for (int i = 0; i < 2; ++i) {
            const float4 a0 = *(const float4*)(pa + i * 512 + lane * 8), a1 = *(const float4*)(pa + i * 512 + lane * 8 + 4);
            const float4 b0 = *(const float4*)(pb + i * 512 + lane * 8), b1 = *(const float4*)(pb + i * 512 + lane * 8 + 4);
            xa[i * 8] = a0.x; xa[i * 8 + 1] = a0.y; xa[i * 8 + 2] = a0.z; xa[i * 8 + 3] = a0.w; xa[i * 8 + 4] = a1.x; xa[i * 8 + 5] = a1.y; xa[i * 8 + 6] = a1.z; xa[i * 8 + 7] = a1.w;
            xb[i * 8] = b0.x; xb[i * 8 + 1] = b0.y; xb[i * 8 + 2] = b0.z; xb[i * 8 + 3] = b0.w; xb[i * 8 + 4] = b1.x; xb[i * 8 + 5] = b1.y; xb[i * 8 + 6] = b1.z; xb[i * 8 + 7] = b1.w;
        }
    } else {
        const bf16_t* pa = (const bf16_t*)(P.ws + OFF_XB) + (size_t)row0 * D; const bf16_t* pb = pa + D;
#pragma unroll
        for (int i = 0; i < 2; ++i) { unpack8(*(const uint4*)(pa + i * 512 + lane * 8), xa + i * 8); unpack8(*(const uint4*)(pb + i * 512 + lane * 8), xb + i * 8); }
    }
    float sa = 0.f, sb = 0.f;
#pragma unroll
    for (int e = 0; e < 16; ++e) { sa += xa[e] * xa[e]; sb += xb[e] * xb[e]; }
#pragma unroll
    for (int o = 32; o >= 1; o >>= 1) { sa += __shfl_xor(sa, o); sb += __shfl_xor(sb, o); }
    const float ra = rsqrtf(sa * (1.f / 1024.f) + 1e-6f), rb = rsqrtf(sb * (1.f / 1024.f) + 1e-6f);
#pragma unroll
    for (int i = 0; i < 2; ++i) {
        const int c = i * 512 + lane * 8;
        const float4 g0 = *(const float4*)(ng + c), g1 = *(const float4*)(ng + c + 4), h0 = *(const float4*)(mod + c), h1 = *(const float4*)(mod + c + 4);
        const float4 s0 = *(const float4*)(mod + 1024 + c), s1 = *(const float4*)(mod + 1024 + c + 4);
        const float gs[8] = {g0.x * (1.f + s0.x), g0.y * (1.f + s0.y), g0.z * (1.f + s0.z), g0.w * (1.f + s0.w), g1.x * (1.f + s1.x), g1.y * (1.f + s1.y), g1.z * (1.f + s1.z), g1.w * (1.f + s1.w)};
        const float sh[8] = {h0.x, h0.y, h0.z, h0.w, h1.x, h1.y, h1.z, h1.w};
        uint4 oa, ob;
        oa.x = pack2(xa[i * 8] * ra * gs[0] + sh[0], xa[i * 8 + 1] * ra * gs[1] + sh[1]); oa.y = pack2(xa[i * 8 + 2] * ra * gs[2] + sh[2], xa[i * 8 + 3] * ra * gs[3] + sh[3]);
        oa.z = pack2(xa[i * 8 + 4] * ra * gs[4] + sh[4], xa[i * 8 + 5] * ra * gs[5] + sh[5]); oa.w = pack2(xa[i * 8 + 6] * ra * gs[6] + sh[6], xa[i * 8 + 7] * ra * gs[7] + sh[7]);
        ob.x = pack2(xb[i * 8] * rb * gs[0] + sh[0], xb[i * 8 + 1] * rb * gs[1] + sh[1]); ob.y = pack2(xb[i * 8 + 2] * rb * gs[2] + sh[2], xb[i * 8 + 3] * rb * gs[3] + sh[3]);
        ob.z = pack2(xb[i * 8 + 4] * rb * gs[4] + sh[4], xb[i * 8 + 5] * rb * gs[5] + sh[5]); ob.w = pack2(xb[i * 8 + 6] * rb * gs[6] + sh[6], xb[i * 8 + 7] * rb * gs[7] + sh[7]);
        *(uint4*)(ha + c) = oa; *(uint4*)(hb + c) = ob;
    }
}
DEV void expand_my_chunk(const Params& P, int l, size_t e0) {
    const int c0 = (int)(e0 % 768), r = (int)((e0 / 768) % 512), g = (int)(e0 / (768 * 512));
    const int t = r >> 4, p = r & 15;
    float v[8];
    if (c0 < 512) {
        const int s = c0 >> 4, q0 = c0 & 15;
        const float* kt = (const float*)(P.ws + OFF_KTAB) + ((size_t)((l * 32 + g) * 2) * 32) * 256;
        if (t > s) { const float* src = kt + (size_t)(t - s) * 256 + p * 16 + q0;
#pragma unroll
            for (int j = 0; j < 8; ++j) v[j] = src[j];
        } else if (t < s) { const float* src = kt + (size_t)(32 + (s - t)) * 256 + p * 16 + q0;
#pragma unroll
            for (int j = 0; j < 8; ++j) v[j] = src[j];
        } else { const float dsk = P.in[I_SD][l * 512 + g * 16 + p];
#pragma unroll
            for (int j = 0; j < 8; ++j) v[j] = kt[p * 16 + q0 + j] + kt[32 * 256 + p * 16 + q0 + j] + ((q0 + j) == p ? dsk : 0.f);
        }
    } else {
        const int cp = c0 - 512, d = cp >> 7, part = (cp >> 6) & 1, n0 = cp & 63;
        const float k = d == 0 ? (float)(t + 1) : (float)(32 - t);
#pragma unroll
        for (int j = 0; j < 8; ++j) {
            const int n = n0 + j; const Disc dc = s5_disc_tab(P, l, d, g, n); float pr, pi; cpow(dc, k, pr, pi);
            const float cr = P.in[I_CRE][((size_t)(l * 32 + g) * 16 + p) * 64 + n], ci = P.in[I_CIM][((size_t)(l * 32 + g) * 16 + p) * 64 + n];
            v[j] = part == 0 ? (cr * pr - ci * pi) : -(cr * pi + ci * pr);
        }
    }
    uint4 o; o.x = pack2(v[0], v[1]); o.y = pack2(v[2], v[3]); o.z = pack2(v[4], v[5]); o.w = pack2(v[6], v[7]);
    *(uint4*)((bf16_t*)(P.ws + OFF_MY) + e0) = o;
}
DEV void expand_mh_chunk(const Params& P, int l, size_t e0) {
    const int c0 = (int)(e0 % 512), r = (int)((e0 / 512) % 256), g = (int)(e0 / (512 * 256));
    const int d = r >> 7, part = (r >> 6) & 1, n = r & 63, s = c0 >> 4, q0 = c0 & 15;
    const float k = d == 0 ? (float)(31 - s) : (float)s;
    const Disc dc = s5_disc_tab(P, l, d, g, n); float pr, pi; cpow(dc, k, pr, pi);
    const float wr = pr * dc.cr - pi * dc.ci, wi = pr * dc.ci + pi * dc.cr;
    const float* bre = P.in[I_BRE] + ((size_t)(l * 32 + g) * 64 + n) * 16 + q0; const float* bim = P.in[I_BIM] + ((size_t)(l * 32 + g) * 64 + n) * 16 + q0;
    float v[8];
#pragma unroll
    for (int j = 0; j < 8; ++j) v[j] = part == 0 ? (wr * bre[j] - wi * bim[j]) : (wr * bim[j] + wi * bre[j]);
    uint4 o; o.x = pack2(v[0], v[1]); o.y = pack2(v[2], v[3]); o.z = pack2(v[4], v[5]); o.w = pack2(v[6], v[7]);
    *(uint4*)((bf16_t*)(P.ws + OFF_MH) + e0) = o;
}
constexpr int PA_NORM = NTOK / 8, PA_MY = 32 * 512 * 768 / 8192, PA_MH = 32 * 256 * 512 / 8192;
DEV void phase_A(const Params& P, int l, int tid, int bid, int nb) {
    const int total = PA_NORM + PA_MY + PA_MH;
    for (int it = bid; it < total; it += nb) {
        if (it < PA_MY) {
#pragma unroll
            for (int u = 0; u < 4; ++u) expand_my_chunk(P, l, ((size_t)(it * 4 + u) * 256 + tid) * 8);
        } else if (it < PA_MY + PA_MH) {
#pragma unroll
            for (int u = 0; u < 4; ++u) expand_mh_chunk(P, l, ((size_t)((it - PA_MY) * 4 + u) * 256 + tid) * 8);
        } else norm_item(P, l, it - PA_MY - PA_MH, tid);
    }
}

DEV void phase_B(const Params& P, int l, unsigned char* smem, int tid, int bid, int nb) {
    GemmDesc G; G.A = (const bf16_t*)(P.ws + OFF_HMIX); G.lda = D; G.M = NTOK; G.B = (const bf16_t*)(P.ws + OFF_WIN) + (size_t)l * INW * D; G.ldb = D; G.N = INW; G.K = D;
    EpiInProj epi; epi.abuf = (bf16_t*)(P.ws + OFF_ABUF); epi.pbuf = (bf16_t*)(P.ws + OFF_PBUF); epi.lrbuf = (float*)(P.ws + OFF_LR);
    const int total = (NTOK / 128) * 21;
    GR_DECL bool pre = false;
    for (int it = bid; it < total; it += nb) {
        const int j = it >> 3, nx = it + nb, jn = nx >> 3; const bool hn = nx < total;
        gemm_tile(G, ((j / 21) * 8 + (it & 7)) * 128, (j % 21) * 128, epi, GR_ARGS, pre, hn, G, ((jn / 21) * 8 + (nx & 7)) * 128, (jn % 21) * 128, smem, tid); pre = hn;
    }
}

DEV int gla_row(int b, int c, int i) {
    if (c < 4) return b * 256 + c * 64 + i;
    const int cc = c - 4; return NCTX + b * SEQ + ((((cc & 1) * 64) + i) << 6) + (cc >> 1);
}
typedef short s16x4 __attribute__((ext_vector_type(4)));
DEV bf16x8 tr_frag(const bf16_t* img, int stride, int col0, int k0, int lane) {
    const int grp = lane >> 4, li = lane & 15, q = li >> 2, p = li & 3;
    const bf16_t* a = img + (k0 + (grp >> 1) * 8 + q) * stride + col0 + (grp & 1) * 16 + 4 * p;
    const s16x4 lo = __builtin_amdgcn_ds_read_tr16_b64_v4i16((LAS s16x4*)a);
    const s16x4 hi = __builtin_amdgcn_ds_read_tr16_b64_v4i16((LAS s16x4*)(a + 4 * stride));
    bf16x8 r; r[0] = lo[0]; r[1] = lo[1]; r[2] = lo[2]; r[3] = lo[3]; r[4] = hi[0]; r[5] = hi[1]; r[6] = hi[2]; r[7] = hi[3];
    return r;
}
DEV void gla_stage_gate(const Params& P, int l, int b, int c, int d, int h, bf16_t* lrA, bf16_t* wB, int tid) {
    {
        const int i = tid >> 2, r0 = (tid & 3) * 4;
        const float4 x = *(const float4*)((const float*)(P.ws + OFF_LR) + (size_t)gla_row(b, c, i) * 32 + d * 16 + r0);
        const bf16_t h0 = f2bf(x.x), h1 = f2bf(x.y), h2 = f2bf(x.z), h3 = f2bf(x.w);
        uint2 hi, lo; hi.x = (unsigned)h0 | ((unsigned)h1 << 16); hi.y = (unsigned)h2 | ((unsigned)h3 << 16);
        lo.x = pack2(x.x - bf2f(h0), x.y - bf2f(h1)); lo.y = pack2(x.z - bf2f(h2), x.w - bf2f(h3));
        *(uint2*)(lrA + i * 40 + r0) = hi; *(uint2*)(lrA + i * 40 + 16 + r0) = lo;
    }
    {
        const int dk = tid & 63, rq = (tid >> 6) * 4;
#pragma unroll
        for (int u = 0; u < 4; ++u) {
            const float wv = P.in[I_WGATE][(size_t)((l * 2 + d) * 16 + rq + u) * 256 + h * 64 + dk];
            const bf16_t hv = f2bf(wv);
            wB[dk * 40 + rq + u] = hv; wB[dk * 40 + 16 + rq + u] = f2bf(wv - bf2f(hv));
        }
    }
}
DEV void gla_gc_mfma(const Params& P, int l, int d, int h, const bf16_t* lrA, const bf16_t* wB, float* gc, float* tot_s, int tid) {
    const int lane = tid & 63, w = tid >> 6, fr = lane & 31, hh = lane >> 5, fh = hh * 8, mi = w >> 1, nj = w & 1;
    const bf16x8 ahi = *(const bf16x8*)(lrA + (mi * 32 + fr) * 40 + fh), alo = *(const bf16x8*)(lrA + (mi * 32 + fr) * 40 + 16 + fh);
    const bf16x8 bhi = *(const bf16x8*)(wB + (nj * 32 + fr) * 40 + fh), blo = *(const bf16x8*)(wB + (nj * 32 + fr) * 40 + 16 + fh);
    f32x16 z;
#pragma unroll
    for (int r = 0; r < 16; ++r) z[r] = 0.f;
    z = __builtin_amdgcn_mfma_f32_32x32x16_bf16(ahi, bhi, z, 0, 0, 0);
    z = __builtin_amdgcn_mfma_f32_32x32x16_bf16(alo, bhi, z, 0, 0, 0);
    z = __builtin_amdgcn_mfma_f32_32x32x16_bf16(ahi, blo, z, 0, 0, 0);
    const int dk = nj * 32 + fr;
    const float bg = P.in[I_BGATE][(l * 2 + d) * 256 + h * 64 + dk];
    float x[16];
#pragma unroll
    for (int r = 0; r < 16; ++r) { const float zz = fmaxf(z[r] + bg, -80.f); x[r] = __builtin_amdgcn_logf(1.f + __builtin_amdgcn_exp2f(zz * -1.4426950408889634f)) * -0.0625f; }
    float S[4], T[4], base[4];
    if (d == 0) {
#pragma unroll
        for (int g = 0; g < 4; ++g) { x[4 * g + 1] += x[4 * g]; x[4 * g + 2] += x[4 * g + 1]; x[4 * g + 3] += x[4 * g + 2]; S[g] = x[4 * g + 3]; }
    } else {
#pragma unroll
        for (int g = 0; g < 4; ++g) { x[4 * g + 2] += x[4 * g + 3]; x[4 * g + 1] += x[4 * g + 2]; x[4 * g] += x[4 * g + 1]; S[g] = x[4 * g]; }
    }
#pragma unroll
    for (int g = 0; g < 4; ++g) T[g] = __shfl_xor(S[g], 32);
    float run = 0.f;
    if (d == 0) {
#pragma unroll
        for (int g = 0; g < 4; ++g) { base[g] = run + (hh ? T[g] : 0.f); run += S[g] + T[g]; }
    } else {
#pragma unroll
        for (int g = 3; g >= 0; --g) { base[g] = run + (hh ? 0.f : T[g]); run += S[g] + T[g]; }
    }
    if (hh == 0) tot_s[mi * 64 + dk] = run;
    __syncthreads();
    const float off = d == 0 ? (mi == 1 ? tot_s[dk] : 0.f) : (mi == 0 ? tot_s[64 + dk] : 0.f);
#pragma unroll
    for (int g = 0; g < 4; ++g)
#pragma unroll
        for (int j = 0; j < 4; ++j) gc[(mi * 32 + 8 * g + 4 * hh + j) * 64 + dk] = x[4 * g + j] + base[g] + off;
    __syncthreads();
}
DEV void gla_load_v(const Params& P, int b, int c, int h, bf16_t* Vs, int tid) {
    const int i = tid >> 2, dv0 = (tid & 3) * 32;
    const bf16_t* src = (const bf16_t*)(P.ws + OFF_PBUF) + (size_t)gla_row(b, c, i) * PW + 1024 + h * 128 + dv0;
#pragma unroll
    for (int u = 0; u < 4; ++u) *(uint4*)(Vs + i * 160 + dv0 + u * 8) = *(const uint4*)(src + u * 8);
}

#define GLP_PARAMS float4& p_lr, float4& p_w, uint4& p_v0, uint4& p_v1, uint4& p_v2, uint4& p_v3, uint4& p_k0, uint4& p_k1
DEV void gla_local_load(const Params& P, int l, int item, int tid, GLP_PARAMS) {
    const int d = item & 1, c = (item >> 1) % NCH, bh = (item >> 1) / NCH, h = bh & 3, b = bh >> 2;
    { const int i = tid >> 2, r0 = (tid & 3) * 4; p_lr = *(const float4*)((const float*)(P.ws + OFF_LR) + (size_t)gla_row(b, c, i) * 32 + d * 16 + r0); }
    { const int dk = tid & 63, rq = (tid >> 6) * 4; const float* wp = P.in[I_WGATE] + (size_t)((l * 2 + d) * 16 + rq) * 256 + h * 64 + dk;
      p_w.x = wp[0]; p_w.y = wp[256]; p_w.z = wp[512]; p_w.w = wp[768]; }
    { const int i = tid >> 2, dv0 = (tid & 3) * 32; const bf16_t* src = (const bf16_t*)(P.ws + OFF_PBUF) + (size_t)gla_row(b, c, i) * PW + 1024 + h * 128 + dv0;
      p_v0 = *(const uint4*)(src); p_v1 = *(const uint4*)(src + 8); p_v2 = *(const uint4*)(src + 16); p_v3 = *(const uint4*)(src + 24); }
    { const int kj = tid >> 2, dk0 = (tid & 3) * 16; const bf16_t* ksrc = (const bf16_t*)(P.ws + OFF_PBUF) + (size_t)gla_row(b, c, kj) * PW + 768 + h * 64 + dk0;
      p_k0 = *(const uint4*)(ksrc); p_k1 = *(const uint4*)(ksrc + 8); }
}
DEV void gla_stage_gate_regs(const float4& x, const float4& wv4, bf16_t* lrA, bf16_t* wB, int tid) {
    {
        const int i = tid >> 2, r0 = (tid & 3) * 4;
        const bf16_t h0 = f2bf(x.x), h1 = f2bf(x.y), h2 = f2bf(x.z), h3 = f2bf(x.w);
        uint2 hi, lo; hi.x = (unsigned)h0 | ((unsigned)h1 << 16); hi.y = (unsigned)h2 | ((unsigned)h3 << 16);
        lo.x = pack2(x.x - bf2f(h0), x.y - bf2f(h1)); lo.y = pack2(x.z - bf2f(h2), x.w - bf2f(h3));
        *(uint2*)(lrA + i * 40 + r0) = hi; *(uint2*)(lrA + i * 40 + 16 + r0) = lo;
    }
    {
        const int dk = tid & 63, rq = (tid >> 6) * 4;
        const float wv[4] = {wv4.x, wv4.y, wv4.z, wv4.w};
#pragma unroll
        for (int u = 0; u < 4; ++u) { const bf16_t hv = f2bf(wv[u]); wB[dk * 40 + rq + u] = hv; wB[dk * 40 + 16 + rq + u] = f2bf(wv[u] - bf2f(hv)); }
    }
}
DEV void gla_local_item(const Params& P, int l, int item, unsigned char* smem, int tid, const float4& p_lr, const float4& p_w, const uint4& p_v0, const uint4& p_v1, const uint4& p_v2, const uint4& p_v3, const uint4& w0, const uint4& w1) {
    const int d = item & 1, c = (item >> 1) % NCH, bh = (item >> 1) / NCH, h = bh & 3, b = bh >> 2;
    float* gc = (float*)smem; bf16_t* kd = (bf16_t*)(smem + 16384); bf16_t* Vs = (bf16_t*)(smem + 28672);
    bf16_t* lrA = (bf16_t*)(smem + 49152); bf16_t* wB = (bf16_t*)(smem + 54272); float* tot_s = (float*)(smem + 59392);
    gla_stage_gate_regs(p_lr, p_w, lrA, wB, tid);
    { const int i = tid >> 2, dv0 = (tid & 3) * 32; bf16_t* dst = Vs + i * 160 + dv0; *(uint4*)(dst) = p_v0; *(uint4*)(dst + 8) = p_v1; *(uint4*)(dst + 16) = p_v2; *(uint4*)(dst + 24) = p_v3; }
    const int chain = (b * 4 + h) * 2 + d;
    const int kj = tid >> 2, dk0 = (tid & 3) * 16;
    __syncthreads();
    gla_gc_mfma(P, l, d, h, lrA, wB, gc, tot_s, tid);
    {
        const unsigned ww[8] = {w0.x, w0.y, w0.z, w0.w, w1.x, w1.y, w1.z, w1.w};
        const float* gtot = gc + (d == 0 ? 63 * 64 : 0);
        unsigned ko[8];
#pragma unroll
        for (int e = 0; e < 8; ++e) {
            const int dk = dk0 + 2 * e;
            const float k0 = __uint_as_float(ww[e] << 16), k1 = __uint_as_float(ww[e] & 0xffff0000u);
            ko[e] = pack2(k0 * __builtin_amdgcn_exp2f(gtot[dk] - gc[kj * 64 + dk]), k1 * __builtin_amdgcn_exp2f(gtot[dk + 1] - gc[kj * 64 + dk + 1]));
        }
        *(uint4*)(kd + kj * 96 + dk0) = make_uint4(ko[0], ko[1], ko[2], ko[3]); *(uint4*)(kd + kj * 96 + dk0 + 8) = make_uint4(ko[4], ko[5], ko[6], ko[7]);
        if (tid < 64) ((float*)(P.ws + OFF_DEC))[(size_t)(chain * NCH + c) * 64 + tid] = __builtin_amdgcn_exp2f(gtot[tid]);
    }
    __syncthreads();
    const int lane = tid & 63, w = tid >> 6, fr = lane & 31, hh = lane >> 5;
    f32x16 acc[2];
#pragma unroll
    for (int nj = 0; nj < 2; ++nj)
#pragma unroll
        for (int r = 0; r < 16; ++r) acc[nj][r] = 0.f;
#pragma unroll
    for (int ks = 0; ks < 4; ++ks) {
        const bf16x8 bv = tr_frag(Vs, 160, w * 32, ks * 16, lane);
        const bf16x8 a0 = tr_frag(kd, 96, 0, ks * 16, lane), a1 = tr_frag(kd, 96, 32, ks * 16, lane);
        acc[0] = __builtin_amdgcn_mfma_f32_32x32x16_bf16(a0, bv, acc[0], 0, 0, 0);
        acc[1] = __builtin_amdgcn_mfma_f32_32x32x16_bf16(a1, bv, acc[1], 0, 0, 0);
    }
    bf16_t* ds = (bf16_t*)(P.ws + OFF_DS) + (size_t)(chain * NCH + c) * 8192 + (w * 32 + fr) * 64;
#pragma unroll
    for (int nj = 0; nj < 2; ++nj)
#pragma unroll
        for (int g = 0; g < 4; ++g) {
            uint2 o; o.x = pack2(acc[nj][4 * g], acc[nj][4 * g + 1]); o.y = pack2(acc[nj][4 * g + 2], acc[nj][4 * g + 3]);
            *(uint2*)(ds + nj * 32 + 8 * g + 4 * hh) = o;
        }
    __syncthreads();
}
constexpr int PC_S5 = 32 * 9 * 2, PC_GLA = NB * 4 * NCH * 2;
DEV void phase_C(const Params& P, int l, unsigned char* smem, int tid_, int bid, int nb) {
    const int tid_in = tid_;
    {
        float4 a_lr, a_w, b_lr, b_w; uint4 a_v0, a_v1, a_v2, a_v3, a_k0, a_k1, b_v0, b_v1, b_v2, b_v3, b_k0, b_k1;
        a_lr = a_w = b_lr = b_w = make_float4(0.f, 0.f, 0.f, 0.f); a_v0 = a_v1 = a_v2 = a_v3 = a_k0 = a_k1 = b_v0 = b_v1 = b_v2 = b_v3 = b_k0 = b_k1 = make_uint4(0u, 0u, 0u, 0u);
        int it = bid;
        if (it < PC_GLA) gla_local_load(P, l, it, tid_in, a_lr, a_w, a_v0, a_v1, a_v2, a_v3, a_k0, a_k1);
        while (it < PC_GLA) {
            { int tid = tid_in; asm volatile("" : "+v"(tid));
              const int nx = it + nb; if (nx < PC_GLA) gla_local_load(P, l, nx, tid, b_lr, b_w, b_v0, b_v1, b_v2, b_v3, b_k0, b_k1);
              gla_local_item(P, l, it, smem, tid, a_lr, a_w, a_v0, a_v1, a_v2, a_v3, a_k0, a_k1); it = nx; }
            if (it >= PC_GLA) break;
            { int tid = tid_in; asm volatile("" : "+v"(tid));
              const int nx = it + nb; if (nx < PC_GLA) gla_local_load(P, l, nx, tid, a_lr, a_w, a_v0, a_v1, a_v2, a_v3, a_k0, a_k1);
              gla_local_item(P, l, it, smem, tid, b_lr, b_w, b_v0, b_v1, b_v2, b_v3, b_k0, b_k1); it = nx; }
        }
    }
    int tid = tid_in; asm volatile("" : "+v"(tid));
    GR_DECL bool pre = false;
    auto mk = [&](int item, GemmDesc& G, EpiHloc& epi, int& m0, int& n0) {
        const int j = item >> 3, g = (j / 18) * 8 + (item & 7), mt = (j % 18) >> 1, nt = j & 1;
        G.A = (const bf16_t*)(P.ws + OFF_ABUF) + (size_t)g * NSUB * 768; G.lda = 768; G.M = NSUB;
        G.B = (const bf16_t*)(P.ws + OFF_MH) + (size_t)g * 256 * 512; G.ldb = 512; G.N = 256; G.K = 512;
        epi.hloc = (float*)(P.ws + OFF_HY) + (size_t)g * NSUB * 256; m0 = mt * 128; n0 = nt * 128;
    };
    for (int item = nb - 1 - bid; item < PC_S5; item += nb) {
        GemmDesc G, Gn; EpiHloc epi, epin; int m0, n0, m0n, n0n; const int nx = item + nb; const bool hn = nx < PC_S5;
        mk(item, G, epi, m0, n0); mk(hn ? nx : item, Gn, epin, m0n, n0n);
        gemm_tile(G, m0, n0, epi, GR_ARGS, pre, hn, Gn, m0n, n0n, smem, tid); pre = hn;
    }
}

DEV void s5_scan_item(const Params& P, int l, int item, int tid) {
    const int idx = item * 256 + tid, n = idx & 63, d = (idx >> 6) & 1, g = (idx >> 7) & 31, b = idx >> 12;
    const float* lamT = (const float*)(P.ws + OFF_LAMT) + (size_t)(((l * 2 + d) * 32 + g) * 64 + n) * 2;
    const float ltr = lamT[0], lti = lamT[1];
    const float* __restrict__ hloc = (const float*)(P.ws + OFF_HY) + (size_t)g * NSUB * 256 + d * 128 + n;
    bf16_t* __restrict__ hin = (bf16_t*)(P.ws + OFF_ABUF) + (size_t)g * NSUB * 768 + 512 + d * 128 + n;
    float hr = 0.f, hi = 0.f;
    for (int s0 = 0; s0 < 264; s0 += 24) {
        float lr_[24], li_[24]; int sub[24];
#pragma unroll
        for (int u = 0; u < 24; ++u) {
            const int step = s0 + u;
            sub[u] = step < 8 ? b * 8 + (d == 0 ? step : 7 - step) : 32 + b * 256 + (d == 0 ? step - 8 : 263 - step);
            lr_[u] = hloc[(size_t)sub[u] * 256]; li_[u] = hloc[(size_t)sub[u] * 256 + 64];
        }
#pragma unroll
        for (int u = 0; u < 24; ++u) {
            hin[(size_t)sub[u] * 768] = f2bf(hr); hin[(size_t)sub[u] * 768 + 64] = f2bf(hi);
            const float nr = ltr * hr - lti * hi + lr_[u], ni = ltr * hi + lti * hr + li_[u];
            hr = nr; hi = ni;
        }
    }
}
DEV int gla_chain_chunk(int d, int step) { return d == 0 ? step : (step < 4 ? 3 - step : 135 - step); }
DEV void gla_scan_item(const Params& P, int item, int tid) {
    const int chain = item >> 4, e2 = (item & 15) * 256 + tid, dk = (e2 * 2) & 63, d = chain & 1;
    unsigned* ds = (unsigned*)(P.ws + OFF_DS) + (size_t)chain * NCH * 4096 + e2;
    const float* dec = (const float*)(P.ws + OFF_DEC) + (size_t)chain * NCH * 64 + dk;
    float s0 = 0.f, s1 = 0.f;
    for (int st = 0; st < NCH; st += 12) {
        unsigned t[12]; float2 dc[12]; int c[12];
#pragma unroll
        for (int u = 0; u < 12; ++u) { c[u] = gla_chain_chunk(d, st + u); t[u] = ds[(size_t)c[u] * 4096]; dc[u] = *(const float2*)(dec + c[u] * 64); }
#pragma unroll
        for (int u = 0; u < 12; ++u) {
            ds[(size_t)c[u] * 4096] = pack2(s0, s1);
            s0 = dc[u].x * s0 + __uint_as_float(t[u] << 16); s1 = dc[u].y * s1 + __uint_as_float(t[u] & 0xffff0000u);
        }
    }
}
constexpr int PD_S5 = 64, PD_GLA = 32 * 16;
DEV void phase_D(const Params& P, int l, int tid, int bid, int nb) {
    const int total = PD_S5 + PD_GLA;
    for (int it = bid; it < total; it += nb) { if (it < PD_S5) s5_scan_item(P, l, it, tid); else gla_scan_item(P, it - PD_S5, tid); }
}

DEV void gla_out_item(const Params& P, int l, int item, unsigned char* smem, int tid) {
    const int c = item % NCH, bh = item / NCH, h = bh & 3, b = bh >> 2;
    float* gc = (float*)smem; bf16_t* qt = (bf16_t*)(smem + 16384); bf16_t* kt = (bf16_t*)(smem + 25600); bf16_t* Pm = (bf16_t*)(smem + 34816);
    bf16_t* Vs = (bf16_t*)(smem + 44032); bf16_t* lrA = (bf16_t*)(smem + 64512); bf16_t* wB = (bf16_t*)(smem + 69632); float* tot_s = (float*)(smem + 74752);
    float* o_s = (float*)smem;
    const int lane = tid & 63, w = tid >> 6, fr = lane & 31, hh = lane >> 5, fh = hh * 8;
    f32x16 acco[2];
#pragma unroll
    for (int mi = 0; mi < 2; ++mi)
#pragma unroll
        for (int r = 0; r < 16; ++r) acco[mi][r] = 0.f;
    gla_load_v(P, b, c, h, Vs, tid);
    for (int d = 0; d < 2; ++d) {
        const int chain = (b * 4 + h) * 2 + d;
        gla_stage_gate(P, l, b, c, d, h, lrA, wB, tid);
        const bf16_t* sp = (const bf16_t*)(P.ws + OFF_DS) + (size_t)(chain * NCH + c) * 8192 + (w * 32 + fr) * 64 + fh;
        bf16x8 sf[4];
#pragma unroll
        for (int ks = 0; ks < 4; ++ks) sf[ks] = *(const bf16x8*)(sp + ks * 16);
        const int qi = tid >> 2, dk0 = (tid & 3) * 16;
        const bf16_t* qsrc = (const bf16_t*)(P.ws + OFF_PBUF) + (size_t)gla_row(b, c, qi) * PW + 512 + h * 64 + dk0;
        const uint4 q0 = *(const uint4*)(qsrc), q1 = *(const uint4*)(qsrc + 8), k0 = *(const uint4*)(qsrc + 256), k1 = *(const uint4*)(qsrc + 264);
        __syncthreads();
        gla_gc_mfma(P, l, d, h, lrA, wB, gc, tot_s, tid);
        {
            const unsigned qq[8] = {q0.x, q0.y, q0.z, q0.w, q1.x, q1.y, q1.z, q1.w}, kk[8] = {k0.x, k0.y, k0.z, k0.w, k1.x, k1.y, k1.z, k1.w};
            unsigned qo[8], ko[8];
#pragma unroll
            for (int e = 0; e < 8; ++e) {
                const float g0 = gc[qi * 64 + dk0 + 2 * e], g1 = gc[qi * 64 + dk0 + 2 * e + 1];
                const float e0 = __builtin_amdgcn_exp2f(g0), e1 = __builtin_amdgcn_exp2f(g1), n0 = __builtin_amdgcn_exp2f(-g0), n1 = __builtin_amdgcn_exp2f(-g1);
                qo[e] = pack2(__uint_as_float(qq[e] << 16) * 0.125f * e0, __uint_as_float(qq[e] & 0xffff0000u) * 0.125f * e1);
                ko[e] = pack2(__uint_as_float(kk[e] << 16) * n0, __uint_as_float(kk[e] & 0xffff0000u) * n1);
            }
            *(uint4*)(qt + qi * 72 + dk0) = make_uint4(qo[0], qo[1], qo[2], qo[3]); *(uint4*)(qt + qi * 72 + dk0 + 8) = make_uint4(qo[4], qo[5], qo[6], qo[7]);
            *(uint4*)(kt + qi * 72 + dk0) = make_uint4(ko[0], ko[1], ko[2], ko[3]); *(uint4*)(kt + qi * 72 + dk0 + 8) = make_uint4(ko[4], ko[5], ko[6], ko[7]);
        }
        __syncthreads();
        {
            const int mj = w >> 1, ni = w & 1;
            f32x16 sc;
#pragma unroll
            for (int r = 0; r < 16; ++r) sc[r] = 0.f;
#pragma unroll
            for (int ks = 0; ks < 4; ++ks) {
                const bf16x8 a = *(const bf16x8*)(kt + (mj * 32 + fr) * 72 + ks * 16 + fh), bb = *(const bf16x8*)(qt + (ni * 32 + fr) * 72 + ks * 16 + fh);
                sc = __builtin_amdgcn_mfma_f32_32x32x16_bf16(a, bb, sc, 0, 0, 0);
            }
            const int i = ni * 32 + fr;
#pragma unroll
            for (int g = 0; g < 4; ++g) {
                const int j0 = mj * 32 + 8 * g + 4 * hh;
                float v[4];
#pragma unroll
                for (int jj = 0; jj < 4; ++jj) { const bool keep = d == 0 ? (j0 + jj <= i) : (j0 + jj >= i); v[jj] = keep ? sc[4 * g + jj] : 0.f; }
                uint2 o; o.x = pack2(v[0], v[1]); o.y = pack2(v[2], v[3]);
                *(uint2*)(Pm + i * 72 + j0) = o;
            }
        }
        __syncthreads();
#pragma unroll
        for (int ks = 0; ks < 4; ++ks) {
            const bf16x8 bv = tr_frag(Vs, 160, w * 32, ks * 16, lane);
            const bf16x8 bs = sf[ks];
            const bf16x8 p0 = *(const bf16x8*)(Pm + fr * 72 + ks * 16 + fh), p1 = *(const bf16x8*)(Pm + (32 + fr) * 72 + ks * 16 + fh);
            const bf16x8 a0 = *(const bf16x8*)(qt + fr * 72 + ks * 16 + fh), a1 = *(const bf16x8*)(qt + (32 + fr) * 72 + ks * 16 + fh);
            acco[0] = __builtin_amdgcn_mfma_f32_32x32x16_bf16(p0, bv, acco[0], 0, 0, 0);
            acco[1] = __builtin_amdgcn_mfma_f32_32x32x16_bf16(p1, bv, acco[1], 0, 0, 0);
            acco[0] = __builtin_amdgcn_mfma_f32_32x32x16_bf16(a0, bs, acco[0], 0, 0, 0);
            acco[1] = __builtin_amdgcn_mfma_f32_32x32x16_bf16(a1, bs, acco[1], 0, 0, 0);
        }
        __syncthreads();
    }
#pragma unroll
    for (int mi = 0; mi < 2; ++mi)
#pragma unroll
        for (int r = 0; r < 16; ++r) { const int i = mi * 32 + (r & 3) + 8 * (r >> 2) + 4 * (lane >> 5); o_s[i * 132 + w * 32 + fr] = acco[mi][r]; }
    __syncthreads();
    {
        const int i = tid >> 2, dv0 = (tid & 3) * 32;
        float ov[32]; float ss = 0.f;
#pragma unroll
        for (int u = 0; u < 8; ++u) { const float4 f = *(const float4*)(o_s + i * 132 + dv0 + u * 4); ov[u * 4] = f.x; ov[u * 4 + 1] = f.y; ov[u * 4 + 2] = f.z; ov[u * 4 + 3] = f.w;
            ss += f.x * f.x + f.y * f.y + f.z * f.z + f.w * f.w; }
        ss += __shfl_xor(ss, 1); ss += __shfl_xor(ss, 2);
        const float rstd = rsqrtf(ss * (1.f / 128.f) + 1e-6f);
        const int row = gla_row(b, c, i);
        const bf16_t* zg = (const bf16_t*)(P.ws + OFF_PBUF) + (size_t)row * PW + 1536 + h * 128 + dv0;
        const float* gn = P.in[I_GNORM] + l * 128 + dv0;
        bf16_t* mo = (bf16_t*)(P.ws + OFF_HMIX) + (size_t)row * D + 512 + h * 128 + dv0;
#pragma unroll
        for (int u = 0; u < 4; ++u) {
            const uint4 z = *(const uint4*)(zg + u * 8); const unsigned zz[4] = {z.x, z.y, z.z, z.w}; unsigned oo[4];
#pragma unroll
            for (int e = 0; e < 4; ++e) {
                const float z0 = __uint_as_float(zz[e] << 16), z1 = __uint_as_float(zz[e] & 0xffff0000u);
                oo[e] = pack2(ov[u * 8 + 2 * e] * rstd * gn[u * 8 + 2 * e] * siluf_(z0), ov[u * 8 + 2 * e + 1] * rstd * gn[u * 8 + 2 * e + 1] * siluf_(z1));
            }
            *(uint4*)(mo + u * 8) = make_uint4(oo[0], oo[1], oo[2], oo[3]);
        }
    }
    __syncthreads();
}
constexpr int PE_S5 = 32 * 9 * 4, PE_GLA = NB * 4 * NCH;
DEV void phase_E(const Params& P, int l, unsigned char* smem, int tid_, int bid, int nb) {
    const int tid_in = tid_;
    for (int it = bid; it < PE_GLA; it += nb) { int tid = tid_in; asm volatile("" : "+v"(tid)); gla_out_item(P, l, it, smem, tid); }
    int tid = tid_in; asm volatile("" : "+v"(tid));
    GR_DECL bool pre = false;
    auto mk = [&](int item, GemmDesc& G, EpiS5Out& epi, int& m0, int& n0) {
        const int j = item >> 3, g = (j / 36) * 8 + (item & 7), mt = (j % 36) >> 2, nt = j & 3;
        G.A = (const bf16_t*)(P.ws + OFF_ABUF) + (size_t)g * NSUB * 768; G.lda = 768; G.M = NSUB;
        G.B = (const bf16_t*)(P.ws + OFF_MY) + (size_t)g * 512 * 768; G.ldb = 768; G.N = 512; G.K = 768;
        epi.ybuf = (bf16_t*)(P.ws + OFF_HY); epi.g = g; m0 = mt * 128; n0 = nt * 128;
    };
    for (int item = nb - 1 - bid; item < PE_S5; item += nb) {
        GemmDesc G, Gn; EpiS5Out epi, epin; int m0, n0, m0n, n0n; const int nx = item + nb; const bool hn = nx < PE_S5;
        mk(item, G, epi, m0, n0); mk(hn ? nx : item, Gn, epin, m0n, n0n);
        gemm_tile(G, m0, n0, epi, GR_ARGS, pre, hn, Gn, m0n, n0n, smem, tid); pre = hn;
    }
}

DEV void phase_F(const Params& P, int l, unsigned char* smem, int tid, int bid, int nb) {
    GemmDesc G; G.A = (const bf16_t*)(P.ws + OFF_HY); G.lda = 512; G.M = NTOK; G.B = (const bf16_t*)(P.ws + OFF_WGLU) + (size_t)l * 512 * 512; G.ldb = 512; G.N = 512; G.K = 512;
    EpiGlu epi; epi.ybuf = (const bf16_t*)(P.ws + OFF_HY); epi.pbuf = (const bf16_t*)(P.ws + OFF_PBUF); epi.bglu = P.in[I_BGLU] + l * 512; epi.mix = (bf16_t*)(P.ws + OFF_HMIX);
    const int total = (NTOK / 128) * 4;
    GR_DECL bool pre = false;
    for (int it = bid + (l == DEPTH - 1 ? 32 : 0); it < total; it += nb) {
        const int j = it >> 3, nx = it + nb, jn = nx >> 3; const bool hn = nx < total;
        gemm_tile(G, ((j >> 2) * 8 + (it & 7)) * 128, (j & 3) * 128, epi, GR_ARGS, pre, hn, G, ((jn >> 2) * 8 + (nx & 7)) * 128, (jn & 3) * 128, smem, tid); pre = hn;
    }
}
DEV void phase_G(const Params& P, int l, unsigned char* smem, int tid, int bid, int nb) {
    GemmDesc G; G.A = (const bf16_t*)(P.ws + OFF_HMIX); G.lda = D; G.M = NTOK; G.B = (const bf16_t*)(P.ws + OFF_WOUT) + (size_t)l * D * D; G.ldb = D; G.N = D; G.K = D;
    EpiOut epi; epi.mod = (const float*)(P.ws + OFF_MOD) + (size_t)l * 5 * 3072; epi.l = l;
    epi.xr_ctx = P.in[I_CTX]; epi.xr_lat = P.in[I_X]; epi.xb_r = (const bf16_t*)(P.ws + OFF_XB); epi.xb_w = (bf16_t*)(P.ws + OFF_XB); epi.out_lat = P.out;
    const int total = (NTOK / 128) * 8;
    GR_DECL bool pre = false;
    for (int it = bid + (l == DEPTH - 1 ? 64 : 0); it < total; it += nb) {
        const int j = it >> 3, nx = it + nb, jn = nx >> 3; const bool hn = nx < total;
        gemm_tile(G, ((j >> 3) * 8 + (it & 7)) * 128, (j & 7) * 128, epi, GR_ARGS, pre, hn, G, ((jn >> 3) * 8 + (nx & 7)) * 128, (jn & 7) * 128, smem, tid); pre = hn;
    }
}
DEV void phase_final(const Params& P, int tid, int bid, int nb) {
    const int total = NB * SEQ / 4;
    for (int it = bid; it < total; it += nb) {
        const int row = it * 4 + (tid >> 6), lane = tid & 63;
        float* x = P.out + (size_t)row * D;
        float4 v[4]; float ss = 0.f;
#pragma unroll
        for (int i = 0; i < 4; ++i) { v[i] = *(const float4*)(x + (i * 64 + lane) * 4); ss += v[i].x * v[i].x + v[i].y * v[i].y + v[i].z * v[i].z + v[i].w * v[i].w; }
#pragma unroll
        for (int o = 32; o >= 1; o >>= 1) ss += __shfl_xor(ss, o);
        const float rstd = rsqrtf(ss * (1.f / 1024.f) + 1e-6f);
#pragma unroll
        for (int i = 0; i < 4; ++i) {
            const int c = (i * 64 + lane) * 4; const float4 g = *(const float4*)(P.in[I_FNORM] + c);
            float4 o; o.x = v[i].x * rstd * g.x; o.y = v[i].y * rstd * g.y; o.z = v[i].z * rstd * g.z; o.w = v[i].w * rstd * g.w;
            *(float4*)(x + c) = o;
        }
    }
}


#define XB_TMO      128
#define XB_XCNT(j)  (256  + 64 * (j))
#define XB_XSUB(j)  (1280 + 64 * (j))
#define XB_XGEN(j)  (2304 + 64 * (j))
#define XB_TOP      3328
#define XB_TOPGEN   3392
#define XCD_BAR_WORDS 3456
#define XB_SPIN_CAP (1u << 20)
DEV unsigned xb_ld(unsigned* p)              { return __hip_atomic_load(p, __ATOMIC_RELAXED, __HIP_MEMORY_SCOPE_AGENT); }
DEV unsigned xb_add(unsigned* p, unsigned v) { return __hip_atomic_fetch_add(p, v, __ATOMIC_RELAXED, __HIP_MEMORY_SCOPE_AGENT); }
DEV unsigned xb_xcc_id() { return (unsigned)__builtin_amdgcn_s_getreg((3 << 11) | 20) & 0xFu; }
#define XB_SPIN(cond, bar) do { unsigned _sp = 0; while (cond) { __builtin_amdgcn_s_sleep(1); \
    if ((++_sp & 255u) == 0u) { if (xb_ld(&(bar)[XB_TMO])) break; if (_sp > XB_SPIN_CAP) { atomicAdd(&(bar)[XB_TMO], 1u); break; } } } } while (0)
struct XcdBarrier { unsigned* bar; unsigned x; volatile LAS unsigned* st; };
DEV XcdBarrier xcd_barrier_post(unsigned* bar, volatile LAS unsigned* st) {
    XcdBarrier b; b.bar = bar; b.x = xb_xcc_id(); b.st = st;
    if (threadIdx.x == 0) (void)xb_add(&bar[XB_XCNT(b.x)], 1u);
    return b;
}
DEV void xcd_barrier_complete(unsigned* bar, unsigned x, unsigned& nloc, unsigned& nx) {
    const unsigned G = gridDim.x * gridDim.y * gridDim.z;
    unsigned sum, cnt, mine, sp = 0u;
    for (;;) {
        sum = 0u; cnt = 0u; mine = 0u;
#pragma unroll
        for (unsigned j = 0; j < 16; ++j) { const unsigned c = xb_ld(&bar[XB_XCNT(j)]); sum += c; cnt += (c > 0u) ? 1u : 0u; mine = (j == x) ? c : mine; }
        if (sum == G) break;
        __builtin_amdgcn_s_sleep(1);
        if ((++sp & 255u) == 0u) { if (xb_ld(&bar[XB_TMO])) break; if (sp > XB_SPIN_CAP) { atomicAdd(&bar[XB_TMO], 1u); break; } }
    }
    nloc = mine > 0u ? mine : 1u; nx = cnt > 0u ? cnt : 1u;
}
DEV void xcd_barrier(const XcdBarrier& b) {
    asm volatile("s_waitcnt vmcnt(0)" ::: "memory");
    __syncthreads();
    if (threadIdx.x == 0) {
        unsigned* bar = b.bar;
        __builtin_amdgcn_s_waitcnt(0);
        unsigned nloc = b.st[0], nx = b.st[1];
        if (nloc == 0u) { xcd_barrier_complete(bar, b.x, nloc, nx); b.st[0] = nloc; b.st[1] = nx; }
        const unsigned old = xb_add(&bar[XB_XSUB(b.x)], 1u);
        const unsigned gen = old / nloc;
        if (old + 1u == (gen + 1u) * nloc) {
            __builtin_amdgcn_fence(__ATOMIC_RELEASE, "agent");
            asm volatile("s_waitcnt vmcnt(0)" ::: "memory");
            const unsigned og = xb_add(&bar[XB_TOP], 1u);
            const unsigned tg = og / nx;
            if (og + 1u == (tg + 1u) * nx) xb_add(&bar[XB_TOPGEN], 1u);
            else XB_SPIN(xb_ld(&bar[XB_TOPGEN]) == tg, bar);
            __builtin_amdgcn_fence(__ATOMIC_ACQUIRE, "agent");
            xb_add(&bar[XB_XGEN(b.x)], 1u);
            asm volatile("s_waitcnt vmcnt(0)" ::: "memory");
        } else {
            XB_SPIN(xb_ld(&bar[XB_XGEN(b.x)]) == gen, bar);
            __builtin_amdgcn_fence(__ATOMIC_ACQUIRE, "agent");
            asm volatile("s_waitcnt vmcnt(0)" ::: "memory");
        }
    }
    __syncthreads();
}

__global__ void __launch_bounds__(NTHREADS, 2) fwd_megakernel(Params P, int ph_lo, int ph_hi) {
    extern __shared__ __attribute__((aligned(16))) unsigned char smem[];
    cg::grid_group grid = cg::this_grid();
    const int tid0 = threadIdx.x, bid0 = blockIdx.x, nb0 = gridDim.x;
    volatile LAS unsigned* xst = (volatile LAS unsigned*)(smem + LDS_MAIN);
    if (tid0 < 4) xst[tid0] = 0u;
    __syncthreads();
    const XcdBarrier xb = xcd_barrier_post((unsigned*)(P.ws + OFF_BAR), xst);
    for (int ph = ph_lo; ph < ph_hi; ++ph) {
        int tid = tid0, bid = bid0, nb = nb0;
        asm volatile("" : "+v"(tid)); asm volatile("" : "+s"(bid)); asm volatile("" : "+s"(nb));
        if (ph == 0) { if (PHMASK & 1) { phase_prep(P, smem, tid, bid, nb); if (REPP0) { asm volatile("" : "+v"(tid)); phase_prep(P, smem, tid, bid, nb); } } }
        else if (ph == NPHASE - 1) { if (PHMASK & 256) phase_final(P, tid, bid, nb); }
        else {
            const int l = (ph - 1) / 7, s = (ph - 1) % 7;
            for (int rep = 0; rep < (((REPMASK >> s) & 1) ? 2 : 1); ++rep) {
            asm volatile("" : "+v"(tid)); asm volatile("" : "+s"(bid)); asm volatile("" : "+s"(nb));
            switch (s) {
                case 0: if (PHMASK & 2) phase_A(P, l, tid, bid, nb); break;
                case 1: if (PHMASK & 4) phase_B(P, l, smem, tid, bid, nb); break;
                case 2: if (PHMASK & 8) phase_C(P, l, smem, tid, bid, nb); break;
                case 3: if (PHMASK & 16) phase_D(P, l, tid, bid, nb); break;
                case 4: if (PHMASK & 32) phase_E(P, l, smem, tid, bid, nb); break;
                case 5: if (PHMASK & 64) phase_F(P, l, smem, tid, bid, nb); break;
                default: if (PHMASK & 128) { phase_G(P, l, smem, tid, bid, nb); if (REPG0 && l == 0) phase_G(P, l, smem, tid, bid, nb); } break;
            }
            }
        }
        if (ph + 1 < ph_hi) { if (ph_hi > 4096) grid.sync(); xcd_barrier(xb); }
    }
}

extern "C" void kernel_launch(void* const* d_in, const int* in_sizes, int n_in, void* d_out, int out_size, void* d_ws, size_t ws_size, hipStream_t stream) {
    static int grid_blocks = 0;
    if (grid_blocks == 0) {
        if (n_in != 23 || ws_size < WS_END) { fprintf(stderr, "kernel_launch: unexpected n_in %d or ws_size %zu (< %zu)\n", n_in, ws_size, (size_t)WS_END); grid_blocks = -1; return; }
        int dev = 0, cus = 0, per_cu = 0;
        hipGetDevice(&dev);
        hipDeviceGetAttribute(&cus, hipDeviceAttributeMultiprocessorCount, dev);
        if (hipFuncSetAttribute((const void*)fwd_megakernel, hipFuncAttributeMaxDynamicSharedMemorySize, LDS_BYTES) != hipSuccess) { fprintf(stderr, "kernel_launch: hipFuncSetAttribute failed\n"); grid_blocks = -1; return; }
        if (hipOccupancyMaxActiveBlocksPerMultiprocessor(&per_cu, (const void*)fwd_megakernel, NTHREADS, LDS_BYTES) != hipSuccess || per_cu < 1) { fprintf(stderr, "kernel_launch: occupancy query failed (%d)\n", per_cu); grid_blocks = -1; return; }
        if (per_cu > 2) per_cu = 2;
        grid_blocks = cus * per_cu;
    }
    if (grid_blocks < 0) return;
    Params p{};
    for (int i = 0; i < 23; ++i) p.in[i] = (const float*)d_in[i];
    p.out = (float*)d_out; p.ws = (unsigned char*)d_ws;
    (void)hipMemsetAsync((unsigned char*)d_ws + OFF_BAR, 0, 3456 * 4, stream);
#if MULTI_LAUNCH
    for (int ph = 0; ph < NPHASE; ++ph) hipLaunchKernelGGL(fwd_megakernel, dim3(grid_blocks), dim3(NTHREADS), LDS_BYTES, stream, p, ph, ph + 1);
#else
    int lo = 0, hi = NPHASE;
    void* args[] = {&p, &lo, &hi};
    hipError_t e = hipLaunchCooperativeKernel((const void*)fwd_megakernel, dim3(grid_blocks), dim3(NTHREADS), args, LDS_BYTES, stream);
    if (e != hipSuccess) fprintf(stderr, "cooperative launch failed: %s (grid %d)\n", hipGetErrorString(e), grid_blocks);
#endif
}
```

```cpp
#include <hip/hip_runtime.h>
#include <hip/hip_cooperative_groups.h>
#include <cstdio>
#include <cstdint>
namespace cg = cooperative_groups;

typedef unsigned short bf16_t;
typedef short bf16x8 __attribute__((ext_vector_type(8)));
typedef float f32x16 __attribute__((ext_vector_type(16)));

#define DEV __device__ __forceinline__
#define LAS __attribute__((address_space(3)))

#ifndef PHMASK
#define PHMASK 0x1ff
#endif
#ifndef REPMASK
#define REPMASK 0
#endif
#ifndef SYNCX
#define SYNCX 0
#endif
#ifndef REPG0
#define REPG0 0
#endif
#ifndef REPD
#define REPD 0
#endif
#ifndef REPP0
#define REPP0 0
#endif
#ifndef EPI_UNROLL
#define EPI_UNROLL 4
#endif
#ifndef MULTI_LAUNCH
#define MULTI_LAUNCH 0
#endif

constexpr int D = 1024, NB = 4, SEQ = 8192, DEPTH = 4, CTXL = 256;
constexpr int NCTX = NB * CTXL;
constexpr int NTOK = NCTX + NB * SEQ;
constexpr int INW = 2592, PW = 2080;
constexpr int NSUB = NTOK / 32;
constexpr int NCH = 132;
constexpr int NTHREADS = 256;
constexpr int LDS_MAIN = 75264;
constexpr int LDS_BYTES = LDS_MAIN + 16;
constexpr int NPHASE = 2 + 7 * DEPTH;

constexpr size_t OFF_XCTX = 0;
constexpr size_t OFF_HMIX = OFF_XCTX + (size_t)NCTX * D * 4;
constexpr size_t OFF_PBUF = OFF_HMIX + (size_t)NTOK * D * 2;
constexpr size_t OFF_ABUF = OFF_PBUF + (size_t)NTOK * PW * 2;
constexpr size_t OFF_HY   = OFF_ABUF + (size_t)32 * NSUB * 768 * 2;
constexpr size_t OFF_DS   = OFF_HY + (size_t)32 * NSUB * 256 * 4;
constexpr size_t OFF_XB   = OFF_DS + (size_t)32 * NCH * 8192 * 2;
constexpr size_t OFF_DEC  = OFF_DS + (size_t)32 * NCH * 8192 * 4;
constexpr size_t OFF_WIN  = OFF_DEC + (size_t)32 * NCH * 64 * 4;
constexpr size_t OFF_WOUT = OFF_WIN + (size_t)DEPTH * INW * D * 2;
constexpr size_t OFF_WGLU = OFF_WOUT + (size_t)DEPTH * D * D * 2;
constexpr size_t OFF_MY   = OFF_WGLU + (size_t)DEPTH * 512 * 512 * 2;
constexpr size_t OFF_MH   = OFF_MY + (size_t)32 * 512 * 768 * 2;
constexpr size_t OFF_KTAB = OFF_MH + (size_t)32 * 256 * 512 * 2;
constexpr size_t OFF_LR   = OFF_KTAB + (size_t)DEPTH * 32 * 2 * 32 * 256 * 4;
constexpr size_t OFF_MOD  = OFF_LR + (size_t)NTOK * 32 * 4;
constexpr size_t OFF_LAMT = OFF_MOD + (size_t)DEPTH * 5 * 3072 * 4;
constexpr size_t OFF_BAR  = OFF_LAMT + (size_t)DEPTH * 2 * 32 * 64 * 2 * 4;
constexpr size_t OFF_DTAB = OFF_BAR + 3456 * 4 + 256;
constexpr size_t WS_END   = OFF_DTAB + (size_t)DEPTH * 2 * 32 * 64 * 16;

struct Params {
    const float* in[23];
    float* out;
    unsigned char* ws;
};
enum { I_X = 0, I_C, I_CTX, I_CCTX, I_NORMG, I_WMOD, I_BMOD, I_WIN, I_LAMRE, I_LAMIM, I_LOGDT, I_BRE, I_BIM, I_CRE, I_CIM, I_SD, I_WGLU, I_BGLU,
       I_WGATE, I_BGATE, I_GNORM, I_WOUT, I_FNORM };

DEV bf16_t f2bf(float f) { const __bf16 h = (__bf16)f; return __builtin_bit_cast(bf16_t, h); }
DEV float bf2f(bf16_t h) { return __uint_as_float(((unsigned)h) << 16); }
typedef float f32x2_t __attribute__((ext_vector_type(2)));
typedef __bf16 bf16x2_t __attribute__((ext_vector_type(2)));
DEV unsigned pack2(float a, float b) { const f32x2_t v = {a, b}; const bf16x2_t h = __builtin_convertvector(v, bf16x2_t); return __builtin_bit_cast(unsigned, h); }
DEV float sigmoidf_(float x) { return __builtin_amdgcn_rcpf(1.f + __builtin_amdgcn_exp2f(x * -1.4426950408889634f)); }
DEV float siluf_(float x) { return x * sigmoidf_(x); }
DEV float gelu_tanh(float x) { float u = 0.7978845608028654f * (x + 0.044715f * x * x * x); return x * sigmoidf_(2.f * u); }
DEV void sincos_rev(float rev, float& s, float& c) { float f = rev - floorf(rev); s = __builtin_amdgcn_sinf(f); c = __builtin_amdgcn_cosf(f); }

struct Disc { float a, rev, cr, ci; };
DEV Disc s5_disc(const Params& P, int l, int d, int g, int n) {
    const int idx = ((l * 2 + d) * 32 + g) * 64 + n;
    const float lr = P.in[I_LAMRE][idx], li = P.in[I_LAMIM][idx];
    const float dt = expf(P.in[I_LOGDT][(l * 2 + d) * 32 + g]);
    Disc o; o.a = lr * dt; const float w = li * dt; o.rev = w * 0.15915494309189535f;
    float s, c, sh, ch; sincos_rev(o.rev, s, c); sincos_rev(0.5f * o.rev, sh, ch);
    const float em1 = expm1f(o.a);
    const float br = em1 * c - 2.f * sh * sh, bi = (em1 + 1.f) * s;
    const float den = lr * lr + li * li;
    o.cr = (br * lr + bi * li) / den; o.ci = (bi * lr - br * li) / den;
    return o;
}
DEV Disc s5_disc_tab(const Params& P, int l, int d, int g, int n) {
    const float4 t = ((const float4*)(P.ws + OFF_DTAB))[((l * 2 + d) * 32 + g) * 64 + n];
    Disc o; o.a = t.x; o.rev = t.y; o.cr = t.z; o.ci = t.w; return o;
}
DEV void cpow(const Disc& dc, float k, float& pr, float& pi) { const float e = __expf(k * dc.a); float s, c; sincos_rev(k * dc.rev, s, c); pr = e * c; pi = e * s; }

DEV const float* xrow_c(const Params& P, int l, int row) {
    if (l == 0) return row < NCTX ? P.in[I_CTX] + (size_t)row * D : P.in[I_X] + (size_t)(row - NCTX) * D;
    return row < NCTX ? (const float*)(P.ws + OFF_XCTX) + (size_t)row * D : P.out + (size_t)(row - NCTX) * D;
}
DEV float* xrow_w(const Params& P, int row) { return row < NCTX ? (float*)(P.ws + OFF_XCTX) + (size_t)row * D : P.out + (size_t)(row - NCTX) * D; }
DEV int mod_row(int row) { return row < NCTX ? 4 : ((row - NCTX) >> 13); }

struct GemmDesc { const bf16_t* A; size_t lda; int M; const bf16_t* B; size_t ldb; int N; int K; };

#define GR_PARAMS uint4& r0a0, uint4& r0a1, uint4& r0a2, uint4& r0a3, uint4& r0b0, uint4& r0b1, uint4& r0b2, uint4& r0b3, uint4& r1a0, uint4& r1a1, uint4& r1a2, uint4& r1a3, uint4& r1b0, uint4& r1b1, uint4& r1b2, uint4& r1b3, uint4& r2a0, uint4& r2a1, uint4& r2a2, uint4& r2a3, uint4& r2b0, uint4& r2b1, uint4& r2b2, uint4& r2b3
#define GR_ARGS r0a0, r0a1, r0a2, r0a3, r0b0, r0b1, r0b2, r0b3, r1a0, r1a1, r1a2, r1a3, r1b0, r1b1, r1b2, r1b3, r2a0, r2a1, r2a2, r2a3, r2b0, r2b1, r2b2, r2b3
#define GR_DECL uint4 r0a0 = make_uint4(0u, 0u, 0u, 0u), r0a1 = make_uint4(0u, 0u, 0u, 0u), r0a2 = make_uint4(0u, 0u, 0u, 0u), r0a3 = make_uint4(0u, 0u, 0u, 0u), r0b0 = make_uint4(0u, 0u, 0u, 0u), r0b1 = make_uint4(0u, 0u, 0u, 0u), r0b2 = make_uint4(0u, 0u, 0u, 0u), r0b3 = make_uint4(0u, 0u, 0u, 0u), r1a0 = make_uint4(0u, 0u, 0u, 0u), r1a1 = make_uint4(0u, 0u, 0u, 0u), r1a2 = make_uint4(0u, 0u, 0u, 0u), r1a3 = make_uint4(0u, 0u, 0u, 0u), r1b0 = make_uint4(0u, 0u, 0u, 0u), r1b1 = make_uint4(0u, 0u, 0u, 0u), r1b2 = make_uint4(0u, 0u, 0u, 0u), r1b3 = make_uint4(0u, 0u, 0u, 0u), r2a0 = make_uint4(0u, 0u, 0u, 0u), r2a1 = make_uint4(0u, 0u, 0u, 0u), r2a2 = make_uint4(0u, 0u, 0u, 0u), r2a3 = make_uint4(0u, 0u, 0u, 0u), r2b0 = make_uint4(0u, 0u, 0u, 0u), r2b1 = make_uint4(0u, 0u, 0u, 0u), r2b2 = make_uint4(0u, 0u, 0u, 0u), r2b3 = make_uint4(0u, 0u, 0u, 0u);
template <class Epi>
DEV void gemm_tile(const GemmDesc& G, int m0, int n0, const Epi& epi, GR_PARAMS, bool preloaded, bool has_next, const GemmDesc& Gn, int m0n, int n0n, unsigned char* smem, int tid) {
    bf16_t* sA = (bf16_t*)smem;
    bf16_t* sB = sA + 2 * 128 * 72;
    const int lane = tid & 63, wave = tid >> 6, wm = wave >> 1, wn = wave & 1;
    const int lr = tid >> 3, kc = (tid & 7) * 8;
    const bf16_t* Abase = G.A + ((size_t)(m0 + lr) * G.lda + kc); const bf16_t* Bbase = G.B + ((size_t)(n0 + lr) * G.ldb + kc);
    const unsigned sa32 = 32u * (unsigned)G.lda, sb32 = 32u * (unsigned)G.ldb;
    f32x16 acc[2][2];
#pragma unroll
    for (int i = 0; i < 2; ++i)
#pragma unroll
        for (int j = 0; j < 2; ++j)
#pragma unroll
            for (int r = 0; r < 16; ++r) acc[i][j][r] = 0.f;
    const int nk = G.K >> 6;
    const int fr = lane & 31, fh = (lane >> 5) * 8;
#define G_LOAD(RA, RB, KT) { G_LOADH0(RA, RB, KT) G_LOADH1(RA, RB, KT) }
#define G_LOADH0(RA, RB, KT) { unsigned sa_ = sa32, sb_ = sb32; asm volatile("" : "+s"(sa_)); asm volatile("" : "+s"(sb_)); \
        const bf16_t* pa_ = Abase + (KT) * 64; const bf16_t* pb_ = Bbase + (KT) * 64; \
        RA##0 = *(const uint4*)(pa_); RB##0 = *(const uint4*)(pb_); RA##1 = *(const uint4*)(pa_ + sa_); RB##1 = *(const uint4*)(pb_ + sb_); }
#define G_LOADH1(RA, RB, KT) { unsigned sa_ = sa32, sb_ = sb32; asm volatile("" : "+s"(sa_)); asm volatile("" : "+s"(sb_)); \
        const bf16_t* pa_ = Abase + (KT) * 64; const bf16_t* pb_ = Bbase + (KT) * 64; \
        RA##2 = *(const uint4*)(pa_ + 2 * sa_); RB##2 = *(const uint4*)(pb_ + 2 * sb_); RA##3 = *(const uint4*)(pa_ + 3 * sa_); RB##3 = *(const uint4*)(pb_ + 3 * sb_); }
#define G_STORE(RA, RB, BUF) { G_STOREH0(RA, RB, BUF) G_STOREH1(RA, RB, BUF) }
#define G_STOREH0(RA, RB, BUF) { bf16_t* dA = sA + (BUF) * (128 * 72); bf16_t* dB = sB + (BUF) * (128 * 72); \
        *(uint4*)(dA + (lr) * 72 + kc) = RA##0; *(uint4*)(dB + (lr) * 72 + kc) = RB##0; *(uint4*)(dA + (lr + 32) * 72 + kc) = RA##1; *(uint4*)(dB + (lr + 32) * 72 + kc) = RB##1; }
#define G_STOREH1(RA, RB, BUF) { bf16_t* dA = sA + (BUF) * (128 * 72); bf16_t* dB = sB + (BUF) * (128 * 72); \
        *(uint4*)(dA + (lr + 64) * 72 + kc) = RA##2; *(uint4*)(dB + (lr + 64) * 72 + kc) = RB##2; *(uint4*)(dA + (lr + 96) * 72 + kc) = RA##3; *(uint4*)(dB + (lr + 96) * 72 + kc) = RB##3; }
#define G_LDA0(KS) { fa0 = *(const bf16x8*)(cA + (KS) * 16); }
#define G_LDA1(KS) { fa1 = *(const bf16x8*)(cA + 32 * 72 + (KS) * 16); }
#define G_LDB(KS, B0, B1) { B0 = *(const bf16x8*)(cB + (KS) * 16); B1 = *(const bf16x8*)(cB + 32 * 72 + (KS) * 16); }
#define G_MM0(B0, B1) { acc[0][0] = __builtin_amdgcn_mfma_f32_32x32x16_bf16(B0, fa0, acc[0][0], 0, 0, 0); acc[0][1] = __builtin_amdgcn_mfma_f32_32x32x16_bf16(B1, fa0, acc[0][1], 0, 0, 0); }
#define G_MM1(B0, B1) { acc[1][0] = __builtin_amdgcn_mfma_f32_32x32x16_bf16(B0, fa1, acc[1][0], 0, 0, 0); acc[1][1] = __builtin_amdgcn_mfma_f32_32x32x16_bf16(B1, fa1, acc[1][1], 0, 0, 0); }
#define G_SB __builtin_amdgcn_sched_barrier(0);
#define G_STEP(RA, RB, KT) { \
        const bf16_t* cA = sA + ((KT) & 1) * (128 * 72) + (wm * 64 + fr) * 72 + fh; \
        const bf16_t* cB = sB + ((KT) & 1) * (128 * 72) + (wn * 64 + fr) * 72 + fh; \
        bf16x8 fa0, fa1, xb0, xb1, yb0, yb1; \
        G_LDA0(0) G_LDB(0, xb0, xb1) G_LDA1(0) G_LDB(1, yb0, yb1) G_SB \
        G_MM0(xb0, xb1) G_SB G_LDA0(1) G_SB G_MM1(xb0, xb1) G_SB G_LDA1(1) G_LDB(2, xb0, xb1) G_SB \
        if ((KT) + 1 < nk) G_STOREH0(RA, RB, ((KT) + 1) & 1) \
        if ((KT) + 4 < nk) G_LOADH0(RA, RB, (KT) + 4) \
        G_SB G_MM0(yb0, yb1) G_SB G_LDA0(2) G_SB G_MM1(yb0, yb1) G_SB G_LDA1(2) G_LDB(3, yb0, yb1) G_SB \
        if ((KT) + 1 < nk) G_STOREH1(RA, RB, ((KT) + 1) & 1) \
        if ((KT) + 4 < nk) G_LOADH1(RA, RB, (KT) + 4) \
        G_SB G_MM0(xb0, xb1) G_SB G_LDA0(3) G_SB G_MM1(xb0, xb1) G_SB G_LDA1(3) G_SB \
        G_MM0(yb0, yb1) G_MM1(yb0, yb1) G_SB \
        __syncthreads(); }
    if (!preloaded) { G_LOAD(r0a, r0b, 0) G_LOAD(r1a, r1b, 1) G_LOAD(r2a, r2b, 2) }
    G_STORE(r0a, r0b, 0)
    __syncthreads();
    G_LOAD(r0a, r0b, 3)
    for (int kt = 0; kt < nk; kt += 3) {
        G_STEP(r1a, r1b, kt)
        if (kt + 1 < nk) G_STEP(r2a, r2b, kt + 1)
        if (kt + 2 < nk) G_STEP(r0a, r0b, kt + 2)
    }
    if (has_next) {
        const bf16_t* Abase = Gn.A + ((size_t)(m0n + lr) * Gn.lda + kc); const bf16_t* Bbase = Gn.B + ((size_t)(n0n + lr) * Gn.ldb + kc);
        const unsigned sa32 = 32u * (unsigned)Gn.lda, sb32 = 32u * (unsigned)Gn.ldb;
        G_LOAD(r0a, r0b, 0) G_LOAD(r1a, r1b, 1) G_LOAD(r2a, r2b, 2)
    }
#undef G_LOAD
#undef G_STORE
#undef G_STEP
#undef G_LDA0
#undef G_LDA1
#undef G_LDB
#undef G_MM0
#undef G_MM1
#undef G_LOADH0
#undef G_LOADH1
#undef G_STOREH0
#undef G_STOREH1
#undef G_SB
    float* sC = (float*)smem;
    int te = tid; asm volatile("" : "+v"(te));
    const int lane_e = te & 63, wave_e = te >> 6, wm_e = wave_e >> 1, wn_e = wave_e & 1, fr_e = lane_e & 31;
#pragma unroll
    for (int i = 0; i < 2; ++i)
#pragma unroll
        for (int j = 0; j < 2; ++j)
#pragma unroll
            for (int g = 0; g < 4; ++g) {
                float4 v; v.x = acc[i][j][4 * g]; v.y = acc[i][j][4 * g + 1]; v.z = acc[i][j][4 * g + 2]; v.w = acc[i][j][4 * g + 3];
                *(float4*)(sC + (wm_e * 64 + i * 32 + fr_e) * 132 + wn_e * 64 + j * 32 + 8 * g + 4 * (lane_e >> 5)) = v;
            }
    __syncthreads();
#pragma unroll EPI_UNROLL
    for (int u = 0; u < 8; ++u) {
        const int c = te + 256 * u, ml = c >> 4, n8 = (c & 15) * 8;
        const float4 v0 = *(const float4*)(sC + ml * 132 + n8), v1 = *(const float4*)(sC + ml * 132 + n8 + 4);
        if (m0 + ml < G.M && n0 + n8 < G.N) epi.vec(m0 + ml, n0 + n8, v0, v1);
    }
    __syncthreads();
}

DEV uint4 pack8(const float4& a, const float4& b) { uint4 o; o.x = pack2(a.x, a.y); o.y = pack2(a.z, a.w); o.z = pack2(b.x, b.y); o.w = pack2(b.z, b.w); return o; }
DEV void unpack8(const uint4& w, float* f) {
    f[0] = __uint_as_float(w.x << 16); f[1] = __uint_as_float(w.x & 0xffff0000u); f[2] = __uint_as_float(w.y << 16); f[3] = __uint_as_float(w.y & 0xffff0000u);
    f[4] = __uint_as_float(w.z << 16); f[5] = __uint_as_float(w.z & 0xffff0000u); f[6] = __uint_as_float(w.w << 16); f[7] = __uint_as_float(w.w & 0xffff0000u);
}
struct EpiInProj {
    bf16_t* abuf; bf16_t* pbuf; float* lrbuf;
    DEV void vec(int m, int n, const float4& a, const float4& b) const {
        const uint4 o = pack8(a, b);
        if (n < 512) *(uint4*)(abuf + ((size_t)(n >> 4) * NSUB + (m >> 5)) * 768 + (m & 31) * 16 + (n & 15)) = o;
        else { *(uint4*)(pbuf + (size_t)m * PW + (n - 512)) = o;
            if (n >= 2560) { *(float4*)(lrbuf + (size_t)m * 32 + (n - 2560)) = a; *(float4*)(lrbuf + (size_t)m * 32 + (n - 2560) + 4) = b; } }
    }
};
struct EpiHloc {
    float* hloc;
    DEV void vec(int m, int n, const float4& a, const float4& b) const { *(float4*)(hloc + (size_t)m * 256 + n) = a; *(float4*)(hloc + (size_t)m * 256 + n + 4) = b; }
};
struct EpiS5Out {
    bf16_t* ybuf; int g;
    DEV void vec(int m, int n, const float4& a, const float4& b) const {
        float4 ga, gb; ga.x = gelu_tanh(a.x); ga.y = gelu_tanh(a.y); ga.z = gelu_tanh(a.z); ga.w = gelu_tanh(a.w); gb.x = gelu_tanh(b.x); gb.y = gelu_tanh(b.y); gb.z = gelu_tanh(b.z); gb.w = gelu_tanh(b.w);
        *(uint4*)(ybuf + ((size_t)m * 32 + (n >> 4)) * 512 + g * 16 + (n & 15)) = pack8(ga, gb);
    }
};
struct EpiGlu {
    const bf16_t* ybuf; const bf16_t* pbuf; const float* bglu; bf16_t* mix;
    DEV void vec(int m, int n, const float4& a, const float4& b) const {
        float y[8], z[8]; unpack8(*(const uint4*)(ybuf + (size_t)m * 512 + n), y); unpack8(*(const uint4*)(pbuf + (size_t)m * PW + n), z);
        const float4 b0 = *(const float4*)(bglu + n), b1 = *(const float4*)(bglu + n + 4);
        float4 oa, ob;
        oa.x = y[0] * sigmoidf_(a.x + b0.x) * siluf_(z[0]); oa.y = y[1] * sigmoidf_(a.y + b0.y) * siluf_(z[1]); oa.z = y[2] * sigmoidf_(a.z + b0.z) * siluf_(z[2]); oa.w = y[3] * sigmoidf_(a.w + b0.w) * siluf_(z[3]);
        ob.x = y[4] * sigmoidf_(b.x + b1.x) * siluf_(z[4]); ob.y = y[5] * sigmoidf_(b.y + b1.y) * siluf_(z[5]); ob.z = y[6] * sigmoidf_(b.z + b1.z) * siluf_(z[6]); ob.w = y[7] * sigmoidf_(b.w + b1.w) * siluf_(z[7]);
        *(uint4*)(mix + (size_t)m * D + n) = pack8(oa, ob);
    }
};
struct EpiOut {
    const float* xr_ctx; const float* xr_lat; const bf16_t* xb_r; bf16_t* xb_w; float* out_lat; const float* mod; int l;
    DEV void vec(int m, int n, const float4& a, const float4& b) const {
        const float* gp = mod + mod_row(m) * 3072 + 2048 + n; const float4 g0 = *(const float4*)gp, g1 = *(const float4*)(gp + 4);
        float xo[8];
        if (l == 0) { const float* xp = m < NCTX ? xr_ctx + (size_t)m * D + n : xr_lat + (size_t)(m - NCTX) * D + n; const float4 x0 = *(const float4*)xp, x1 = *(const float4*)(xp + 4);
            xo[0] = x0.x; xo[1] = x0.y; xo[2] = x0.z; xo[3] = x0.w; xo[4] = x1.x; xo[5] = x1.y; xo[6] = x1.z; xo[7] = x1.w; }
        else unpack8(*(const uint4*)(xb_r + (size_t)m * D + n), xo);
        float4 o0, o1; o0.x = xo[0] + g0.x * a.x; o0.y = xo[1] + g0.y * a.y; o0.z = xo[2] + g0.z * a.z; o0.w = xo[3] + g0.w * a.w;
        o1.x = xo[4] + g1.x * b.x; o1.y = xo[5] + g1.y * b.y; o1.z = xo[6] + g1.z * b.z; o1.w = xo[7] + g1.w * b.w;
        if (l == DEPTH - 1) { float* xw = out_lat + (size_t)(m - NCTX) * D + n; *(float4*)xw = o0; *(float4*)(xw + 4) = o1; }
        else *(uint4*)(xb_w + (size_t)m * D + n) = pack8(o0, o1);
    }
};

DEV void transpose_tile(const float* src, int K, int N, bf16_t* dst, int k0, int n0, float* tile, int tid) {
    const int c = tid & 63, r0 = tid >> 6;
#pragma unroll 4
    for (int i = 0; i < 16; ++i) { const int r = r0 + 4 * i; const int n = n0 + c; tile[r * 65 + c] = (n < N) ? src[(size_t)(k0 + r) * N + n] : 0.f; }
    __syncthreads();
#pragma unroll 4
    for (int i = 0; i < 16; ++i) { const int r = r0 + 4 * i; const int n = n0 + r; if (n < N) dst[(size_t)n * K + k0 + c] = f2bf(tile[c * 65 + r]); }
    __syncthreads();
}

DEV void mod_item(const Params& P, int item, unsigned char* smem, int tid) {
    const int l = item / 48, j0 = (item % 48) * 64;
    float* ssil = (float*)smem;
    float* red = ssil + 5 * 1024;
    for (int i = tid; i < 5 * 1024; i += NTHREADS) { const int r = i >> 10, k = i & 1023; const float cv = r < 4 ? P.in[I_C][r * 1024 + k] : P.in[I_CCTX][k]; ssil[i] = siluf_(cv); }
    __syncthreads();
    const int j = tid & 63, kg = tid >> 6;
    float a0 = 0.f, a1 = 0.f, a2 = 0.f, a3 = 0.f, a4 = 0.f;
    const float* w = P.in[I_WMOD] + (size_t)l * 1024 * 3072 + j0 + j;
#pragma unroll 16
    for (int k = kg * 256; k < kg * 256 + 256; ++k) {
        const float wv = w[(size_t)k * 3072];
        a0 += ssil[k] * wv; a1 += ssil[1024 + k] * wv; a2 += ssil[2048 + k] * wv; a3 += ssil[3072 + k] * wv; a4 += ssil[4096 + k] * wv;
    }
    red[(kg * 5 + 0) * 64 + j] = a0; red[(kg * 5 + 1) * 64 + j] = a1; red[(kg * 5 + 2) * 64 + j] = a2; red[(kg * 5 + 3) * 64 + j] = a3; red[(kg * 5 + 4) * 64 + j] = a4;
    __syncthreads();
    float* mod = (float*)(P.ws + OFF_MOD);
    for (int i = tid; i < 320; i += NTHREADS) {
        const int r = i >> 6, jj = i & 63;
        const float s = red[(0 * 5 + r) * 64 + jj] + red[(1 * 5 + r) * 64 + jj] + red[(2 * 5 + r) * 64 + jj] + red[(3 * 5 + r) * 64 + jj];
        mod[(l * 5 + r) * 3072 + j0 + jj] = s + P.in[I_BMOD][l * 3072 + j0 + jj];
    }
    __syncthreads();
}

DEV void ktab_item(const Params& P, int item, unsigned char* smem, int tid) {
    const int d = item & 1, g = (item >> 1) & 31, l = item >> 6;
    float* sa = (float*)smem; float* srev = sa + 64; float* scr = srev + 64; float* sci = scr + 64;
    float* sBr = sci + 64; float* sBi = sBr + 1024; float* sCr = sBi + 1024; float* sCi = sCr + 1024;
    float* pwr = sCi + 1024; float* pwi = pwr + 2048;
    if (tid < 64) {
        const Disc dc = s5_disc(P, l, d, g, tid);
        sa[tid] = dc.a; srev[tid] = dc.rev; scr[tid] = dc.cr; sci[tid] = dc.ci;
        ((float4*)(P.ws + OFF_DTAB))[((l * 2 + d) * 32 + g) * 64 + tid] = make_float4(dc.a, dc.rev, dc.cr, dc.ci);
        float pr, pi; cpow(dc, 32.f, pr, pi);
        float* lamT = (float*)(P.ws + OFF_LAMT);
        lamT[(((l * 2 + d) * 32 + g) * 64 + tid) * 2 + 0] = pr; lamT[(((l * 2 + d) * 32 + g) * 64 + tid) * 2 + 1] = pi;
    }
    __syncthreads();
#pragma unroll
    for (int i = 0; i < 4; ++i) {
        const int idx = tid + 256 * i, n = idx >> 4;
        const float br = P.in[I_BRE][(size_t)(l * 32 + g) * 1024 + idx], bi = P.in[I_BIM][(size_t)(l * 32 + g) * 1024 + idx];
        sBr[idx] = scr[n] * br - sci[n] * bi; sBi[idx] = scr[n] * bi + sci[n] * br;
        sCr[idx] = P.in[I_CRE][(size_t)(l * 32 + g) * 1024 + idx]; sCi[idx] = P.in[I_CIM][(size_t)(l * 32 + g) * 1024 + idx];
    }
#pragma unroll
    for (int i = 0; i < 8; ++i) {
        const int idx = tid + 256 * i, lag = idx >> 6, n = idx & 63;
        const float e = __expf((float)lag * sa[n]); float s, c; sincos_rev((float)lag * srev[n], s, c);
        pwr[idx] = e * c; pwi[idx] = e * s;
    }
    __syncthreads();
    const int p = tid >> 4, q = tid & 15;
    float* ktab = (float*)(P.ws + OFF_KTAB) + ((size_t)((l * 32 + g) * 2 + d) * 32) * 256;
    for (int lag = 0; lag < 32; ++lag) {
        float acc = 0.f;
#pragma unroll 8
        for (int n = 0; n < 64; ++n) {
            const float cr = sCr[p * 64 + n], ci = sCi[p * 64 + n], pr = pwr[lag * 64 + n], pi = pwi[lag * 64 + n];
            const float zr = cr * pr - ci * pi, zi = cr * pi + ci * pr;
            acc += zr * sBr[n * 16 + q] - zi * sBi[n * 16 + q];
        }
        ktab[lag * 256 + tid] = acc;
    }
    __syncthreads();
}

constexpr int P0_TIN = DEPTH * 16 * 41, P0_TOUT = DEPTH * 16 * 16, P0_TGLU = DEPTH * 8 * 8, P0_MOD = DEPTH * 48, P0_KTAB = DEPTH * 64;
DEV void phase_prep(const Params& P, unsigned char* smem, int tid, int bid, int nb) {
    const int total = P0_TIN + P0_TOUT + P0_TGLU + P0_MOD + P0_KTAB;
    for (int it = bid; it < total; it += nb) {
        int item = it;
        if (item < P0_MOD) { mod_item(P, item, smem, tid); continue; }
        item -= P0_MOD;
        if (item < P0_KTAB) { ktab_item(P, item, smem, tid); continue; }
        item -= P0_KTAB;
        if (item < P0_TIN) { const int l = item / (16 * 41), r = item % (16 * 41);
            transpose_tile(P.in[I_WIN] + (size_t)l * D * INW, D, INW, (bf16_t*)(P.ws + OFF_WIN) + (size_t)l * INW * D, (r / 41) * 64, (r % 41) * 64, (float*)smem, tid); continue; }
        item -= P0_TIN;
        if (item < P0_TOUT) { const int l = item / 256, r = item % 256;
            transpose_tile(P.in[I_WOUT] + (size_t)l * D * D, D, D, (bf16_t*)(P.ws + OFF_WOUT) + (size_t)l * D * D, (r / 16) * 64, (r % 16) * 64, (float*)smem, tid); continue; }
        item -= P0_TOUT;
        { const int l = item / 64, r = item % 64;
            transpose_tile(P.in[I_WGLU] + (size_t)l * 512 * 512, 512, 512, (bf16_t*)(P.ws + OFF_WGLU) + (size_t)l * 512 * 512, (r / 8) * 64, (r % 8) * 64, (float*)smem, tid); }
    }
}

DEV void norm_item(const Params& P, int l, int item, int tid) {
    const int row0 = item * 8 + (tid >> 6) * 2, lane = tid & 63;
    const float* mod = (const float*)(P.ws + OFF_MOD) + (size_t)(l * 5 + mod_row(row0)) * 3072;
    const float* ng = P.in[I_NORMG] + l * 1024;
    bf16_t* ha = (bf16_t*)(P.ws + OFF_HMIX) + (size_t)row0 * D; bf16_t* hb = ha + D;
    float xa[16], xb[16];
    if (l == 0) {
        const float* pa = row0 < NCTX ? P.in[I_CTX] + (size_t)row0 * D : P.in[I_X] + (size_t)(row0 - NCTX) * D; const float* pb = pa + D;
#pragma unroll
        for (int i = 0; i < 2; ++i) {
            const float4 a0 = *(const float4*)(pa + i * 512 + lane * 8), a1 = *(const float4*)(pa + i * 512 + lane * 8 + 4);
            const float4 b0 = *(const float4*)(pb + i * 512 + lane * 8), b1 = *(const float4*)(pb + i * 512 + lane * 8 + 4);
            xa[i * 8] = a0.x; xa[i * 8 + 1] = a0.y; xa[i * 8 + 2] = a0.z; xa[i * 8 + 3] = a0.w; xa[i * 8 + 4] = a1.x; xa[i * 8 + 5] = a1.y; xa[i * 8 + 6] = a1.z; xa[i * 8 + 7] = a1.w;
            xb[i * 8] = b0.x; xb[i * 8 + 1] = b0.y; xb[i * 8 + 2] = b0.z; xb[i * 8 + 3] = b0.w; xb[i * 8 + 4] = b1.x; xb[i * 8 + 5] = b1.y; xb[i * 8 + 6] = b1.z; xb[i * 8 + 7] = b1.w;
        }
    } else {
        const bf16_t* pa = (const bf16_t*)(P.ws + OFF_XB) + (size_t)row0 * D; const bf16_t* pb = pa + D;
#pragma unroll
        for (int i = 0; i < 2; ++i) { unpack8(*(const uint4*)(pa + i * 512 + lane * 8), xa + i * 8); unpack8(*(const uint4*)(pb + i * 512 + lane * 8), xb + i * 8); }
    }
    float sa = 0.f, sb = 0.f;
#pragma unroll
    for (int e = 0; e < 16; ++e) { sa += xa[e] * xa[e]; sb += xb[e] * xb[e]; }
#pragma unroll
    for (int o = 32; o >= 1; o >>= 1) { sa += __shfl_xor(sa, o); sb += __shfl_xor(sb, o); }
    const float ra = rsqrtf(sa * (1.f / 1024.f) + 1e-6f), rb = rsqrtf(sb * (1.f / 1024.f) + 1e-6f);
#pragma unroll
    for (int i = 0; i < 2; ++i) {
        const int c = i * 512 + lane * 8;
        const float4 g0 = *(const float4*)(ng + c), g1 = *(const float4*)(ng + c + 4), h0 = *(const float4*)(mod + c), h1 = *(const float4*)(mod + c + 4);
        const float4 s0 = *(const float4*)(mod + 1024 + c), s1 = *(const float4*)(mod + 1024 + c + 4);
        const float gs[8] = {g0.x * (1.f + s0.x), g0.y * (1.f + s0.y), g0.z * (1.f + s0.z), g0.w * (1.f + s0.w), g1.x * (1.f + s1.x), g1.y * (1.f + s1.y), g1.z * (1.f + s1.z), g1.w * (1.f + s1.w)};
        const float sh[8] = {h0.x, h0.y, h0.z, h0.w, h1.x, h1.y, h1.z, h1.w};
        uint4 oa, ob;
        oa.x = pack2(xa[i * 8] * ra * gs[0] + sh[0], xa[i * 8 + 1] * ra * gs[1] + sh[1]); oa.y = pack2(xa[i * 8 + 2] * ra * gs[2] + sh[2], xa[i * 8 + 3] * ra * gs[3] + sh[3]);
        oa.z = pack2(xa[i * 8 + 4] * ra * gs[4] + sh[4], xa[i * 8 + 5] * ra * gs[5] + sh[5]); oa.w = pack2(xa[i * 8 + 6] * ra * gs[6] + sh[6], xa[i * 8 + 7] * ra * gs[7] + sh[7]);
        ob.x = pack2(xb[i * 8] * rb * gs[0] + sh[0], xb[i * 8 + 1] * rb * gs[1] + sh[1]); ob.y = pack2(xb[i * 8 + 2] * rb * gs[2] + sh[2], xb[i * 8 + 3] * rb * gs[3] + sh[3]);
        ob.z = pack2(xb[i * 8 + 4] * rb * gs[4] + sh[4], xb[i * 8 + 5] * rb * gs[5] + sh[5]); ob.w = pack2(xb[i * 8 + 6] * rb * gs[6] + sh[6], xb[i * 8 + 7] * rb * gs[7] + sh[7]);
        *(uint4*)(ha + c) = oa; *(uint4*)(hb + c) = ob;
    }
}
DEV void expand_my_chunk(const Params& P, int l, size_t e0) {
    const int c0 = (int)(e0 % 768), r = (int)((e0 / 768) % 512), g = (int)(e0 / (768 * 512));
    const int t = r >> 4, p = r & 15;
    float v[8];
    if (c0 < 512) {
        const int s = c0 >> 4, q0 = c0 & 15;
        const float* kt = (const float*)(P.ws + OFF_KTAB) + ((size_t)((l * 32 + g) * 2) * 32) * 256;
        if (t > s) { const float* src = kt + (size_t)(t - s) * 256 + p * 16 + q0;
#pragma unroll
            for (int j = 0; j < 8; ++j) v[j] = src[j];
        } else if (t < s) { const float* src = kt + (size_t)(32 + (s - t)) * 256 + p * 16 + q0;
#pragma unroll
            for (int j = 0; j < 8; ++j) v[j] = src[j];
        } else { const float dsk = P.in[I_SD][l * 512 + g * 16 + p];
#pragma unroll
            for (int j = 0; j < 8; ++j) v[j] = kt[p * 16 + q0 + j] + kt[32 * 256 + p * 16 + q0 + j] + ((q0 + j) == p ? dsk : 0.f);
        }
    } else {
        const int cp = c0 - 512, d = cp >> 7, part = (cp >> 6) & 1, n0 = cp & 63;
        const float k = d == 0 ? (float)(t + 1) : (float)(32 - t);
#pragma unroll
        for (int j = 0; j < 8; ++j) {
            const int n = n0 + j; const Disc dc = s5_disc_tab(P, l, d, g, n); float pr, pi; cpow(dc, k, pr, pi);
            const float cr = P.in[I_CRE][((size_t)(l * 32 + g) * 16 + p) * 64 + n], ci = P.in[I_CIM][((size_t)(l * 32 + g) * 16 + p) * 64 + n];
            v[j] = part == 0 ? (cr * pr - ci * pi) : -(cr * pi + ci * pr);
        }
    }
    uint4 o; o.x = pack2(v[0], v[1]); o.y = pack2(v[2], v[3]); o.z = pack2(v[4], v[5]); o.w = pack2(v[6], v[7]);
    *(uint4*)((bf16_t*)(P.ws + OFF_MY) + e0) = o;
}
DEV void expand_mh_chunk(const Params& P, int l, size_t e0) {
    const int c0 = (int)(e0 % 512), r = (int)((e0 / 512) % 256), g = (int)(e0 / (512 * 256));
    const int d = r >> 7, part = (r >> 6) & 1, n = r & 63, s = c0 >> 4, q0 = c0 & 15;
    const float k = d == 0 ? (float)(31 - s) : (float)s;
    const Disc dc = s5_disc_tab(P, l, d, g, n); float pr, pi; cpow(dc, k, pr, pi);
    const float wr = pr * dc.cr - pi * dc.ci, wi = pr * dc.ci + pi * dc.cr;
    const float* bre = P.in[I_BRE] + ((size_t)(l * 32 + g) * 64 + n) * 16 + q0; const float* bim = P.in[I_BIM] + ((size_t)(l * 32 + g) * 64 + n) * 16 + q0;
    float v[8];
#pragma unroll
    for (int j = 0; j < 8; ++j) v[j] = part == 0 ? (wr * bre[j] - wi * bim[j]) : (wr * bim[j] + wi * bre[j]);
    uint4 o; o.x = pack2(v[0], v[1]); o.y = pack2(v[2], v[3]); o.z = pack2(v[4], v[5]); o.w = pack2(v[6], v[7]);
    *(uint4*)((bf16_t*)(P.ws + OFF_MH) + e0) = o;
}
constexpr int PA_NORM = NTOK / 8, PA_MY = 32 * 512 * 768 / 8192, PA_MH = 32 * 256 * 512 / 8192;
DEV void phase_A(const Params& P, int l, int tid, int bid, int nb) {
    const int total = PA_NORM + PA_MY + PA_MH;
    for (int it = bid; it < total; it += nb) {
        if (it < PA_MY) {
#pragma unroll
            for (int u = 0; u < 4; ++u) expand_my_chunk(P, l, ((size_t)(it * 4 + u) * 256 + tid) * 8);
        } else if (it < PA_MY + PA_MH) {
#pragma unroll
            for (int u = 0; u < 4; ++u) expand_mh_chunk(P, l, ((size_t)((it - PA_MY) * 4 + u) * 256 + tid) * 8);
        } else norm_item(P, l, it - PA_MY - PA_MH, tid);
    }
}

DEV void phase_B(const Params& P, int l, unsigned char* smem, int tid, int bid, int nb) {
    GemmDesc G; G.A = (const bf16_t*)(P.ws + OFF_HMIX); G.lda = D; G.M = NTOK; G.B = (const bf16_t*)(P.ws + OFF_WIN) + (size_t)l * INW * D; G.ldb = D; G.N = INW; G.K = D;
    EpiInProj epi; epi.abuf = (bf16_t*)(P.ws + OFF_ABUF); epi.pbuf = (bf16_t*)(P.ws + OFF_PBUF); epi.lrbuf = (float*)(P.ws + OFF_LR);
    const int total = (NTOK / 128) * 21;
    GR_DECL bool pre = false;
    for (int it = bid; it < total; it += nb) {
        const int j = it >> 3, nx = it + nb, jn = nx >> 3; const bool hn = nx < total;
        gemm_tile(G, ((j / 21) * 8 + (it & 7)) * 128, (j % 21) * 128, epi, GR_ARGS, pre, hn, G, ((jn / 21) * 8 + (nx & 7)) * 128, (jn % 21) * 128, smem, tid); pre = hn;
    }
}

DEV int gla_row(int b, int c, int i) {
    if (c < 4) return b * 256 + c * 64 + i;
    const int cc = c - 4; return NCTX + b * SEQ + ((((cc & 1) * 64) + i) << 6) + (cc >> 1);
}
typedef short s16x4 __attribute__((ext_vector_type(4)));
DEV bf16x8 tr_frag(const bf16_t* img, int stride, int col0, int k0, int lane) {
    const int grp = lane >> 4, li = lane & 15, q = li >> 2, p = li & 3;
    const bf16_t* a = img + (k0 + (grp >> 1) * 8 + q) * stride + col0 + (grp & 1) * 16 + 4 * p;
    const s16x4 lo = __builtin_amdgcn_ds_read_tr16_b64_v4i16((LAS s16x4*)a);
    const s16x4 hi = __builtin_amdgcn_ds_read_tr16_b64_v4i16((LAS s16x4*)(a + 4 * stride));
    bf16x8 r; r[0] = lo[0]; r[1] = lo[1]; r[2] = lo[2]; r[3] = lo[3]; r[4] = hi[0]; r[5] = hi[1]; r[6] = hi[2]; r[7] = hi[3];
    return r;
}
DEV void gla_stage_gate(const Params& P, int l, int b, int c, int d, int h, bf16_t* lrA, bf16_t* wB, int tid) {
    {
        const int i = tid >> 2, r0 = (tid & 3) * 4;
        const float4 x = *(const float4*)((const float*)(P.ws + OFF_LR) + (size_t)gla_row(b, c, i) * 32 + d * 16 + r0);
        const bf16_t h0 = f2bf(x.x), h1 = f2bf(x.y), h2 = f2bf(x.z), h3 = f2bf(x.w);
        uint2 hi, lo; hi.x = (unsigned)h0 | ((unsigned)h1 << 16); hi.y = (unsigned)h2 | ((unsigned)h3 << 16);
        lo.x = pack2(x.x - bf2f(h0), x.y - bf2f(h1)); lo.y = pack2(x.z - bf2f(h2), x.w - bf2f(h3));
        *(uint2*)(lrA + i * 40 + r0) = hi; *(uint2*)(lrA + i * 40 + 16 + r0) = lo;
    }
    {
        const int dk = tid & 63, rq = (tid >> 6) * 4;
#pragma unroll
        for (int u = 0; u < 4; ++u) {
            const float wv = P.in[I_WGATE][(size_t)((l * 2 + d) * 16 + rq + u) * 256 + h * 64 + dk];
            const bf16_t hv = f2bf(wv);
            wB[dk * 40 + rq + u] = hv; wB[dk * 40 + 16 + rq + u] = f2bf(wv - bf2f(hv));
        }
    }
}
DEV void gla_gc_mfma(const Params& P, int l, int d, int h, const bf16_t* lrA, const bf16_t* wB, float* gc, float* tot_s, int tid) {
    const int lane = tid & 63, w = tid >> 6, fr = lane & 31, hh = lane >> 5, fh = hh * 8, mi = w >> 1, nj = w & 1;
    const bf16x8 ahi = *(const bf16x8*)(lrA + (mi * 32 + fr) * 40 + fh), alo = *(const bf16x8*)(lrA + (mi * 32 + fr) * 40 + 16 + fh);
    const bf16x8 bhi = *(const bf16x8*)(wB + (nj * 32 + fr) * 40 + fh), blo = *(const bf16x8*)(wB + (nj * 32 + fr) * 40 + 16 + fh);
    f32x16 z;
#pragma unroll
    for (int r = 0; r < 16; ++r) z[r] = 0.f;
    z = __builtin_amdgcn_mfma_f32_32x32x16_bf16(ahi, bhi, z, 0, 0, 0);
    z = __builtin_amdgcn_mfma_f32_32x32x16_bf16(alo, bhi, z, 0, 0, 0);
    z = __builtin_amdgcn_mfma_f32_32x32x16_bf16(ahi, blo, z, 0, 0, 0);
    const int dk = nj * 32 + fr;
    const float bg = P.in[I_BGATE][(l * 2 + d) * 256 + h * 64 + dk];
    float x[16];
#pragma unroll
    for (int r = 0; r < 16; ++r) { const float zz = fmaxf(z[r] + bg, -80.f); x[r] = __builtin_amdgcn_logf(1.f + __builtin_amdgcn_exp2f(zz * -1.4426950408889634f)) * -0.0625f; }
    float S[4], T[4], base[4];
    if (d == 0) {
#pragma unroll
        for (int g = 0; g < 4; ++g) { x[4 * g + 1] += x[4 * g]; x[4 * g + 2] += x[4 * g + 1]; x[4 * g + 3] += x[4 * g + 2]; S[g] = x[4 * g + 3]; }
    } else {
#pragma unroll
        for (int g = 0; g < 4; ++g) { x[4 * g + 2] += x[4 * g + 3]; x[4 * g + 1] += x[4 * g + 2]; x[4 * g] += x[4 * g + 1]; S[g] = x[4 * g]; }
    }
#pragma unroll
    for (int g = 0; g < 4; ++g) T[g] = __shfl_xor(S[g], 32);
    float run = 0.f;
    if (d == 0) {
#pragma unroll
        for (int g = 0; g < 4; ++g) { base[g] = run + (hh ? T[g] : 0.f); run += S[g] + T[g]; }
    } else {
#pragma unroll
        for (int g = 3; g >= 0; --g) { base[g] = run + (hh ? 0.f : T[g]); run += S[g] + T[g]; }
    }
    if (hh == 0) tot_s[mi * 64 + dk] = run;
    __syncthreads();
    const float off = d == 0 ? (mi == 1 ? tot_s[dk] : 0.f) : (mi == 0 ? tot_s[64 + dk] : 0.f);
#pragma unroll
    for (int g = 0; g < 4; ++g)
#pragma unroll
        for (int j = 0; j < 4; ++j) gc[(mi * 32 + 8 * g + 4 * hh + j) * 64 + dk] = x[4 * g + j] + base[g] + off;
    __syncthreads();
}
DEV void gla_load_v(const Params& P, int b, int c, int h, bf16_t* Vs, int tid) {
    const int i = tid >> 2, dv0 = (tid & 3) * 32;
    const bf16_t* src = (const bf16_t*)(P.ws + OFF_PBUF) + (size_t)gla_row(b, c, i) * PW + 1024 + h * 128 + dv0;
#pragma unroll
    for (int u = 0; u < 4; ++u) *(uint4*)(Vs + i * 160 + dv0 + u * 8) = *(const uint4*)(src + u * 8);
}

#define GLP_PARAMS float4& p_lr, float4& p_w, uint4& p_v0, uint4& p_v1, uint4& p_v2, uint4& p_v3, uint4& p_k0, uint4& p_k1
DEV void gla_local_load(const Params& P, int l, int item, int tid, GLP_PARAMS) {
    const int d = item & 1, c = (item >> 1) % NCH, bh = (item >> 1) / NCH, h = bh & 3, b = bh >> 2;
    { const int i = tid >> 2, r0 = (tid & 3) * 4; p_lr = *(const float4*)((const float*)(P.ws + OFF_LR) + (size_t)gla_row(b, c, i) * 32 + d * 16 + r0); }
    { const int dk = tid & 63, rq = (tid >> 6) * 4; const float* wp = P.in[I_WGATE] + (size_t)((l * 2 + d) * 16 + rq) * 256 + h * 64 + dk;
      p_w.x = wp[0]; p_w.y = wp[256]; p_w.z = wp[512]; p_w.w = wp[768]; }
    { const int i = tid >> 2, dv0 = (tid & 3) * 32; const bf16_t* src = (const bf16_t*)(P.ws + OFF_PBUF) + (size_t)gla_row(b, c, i) * PW + 1024 + h * 128 + dv0;
      p_v0 = *(const uint4*)(src); p_v1 = *(const uint4*)(src + 8); p_v2 = *(const uint4*)(src + 16); p_v3 = *(const uint4*)(src + 24); }
    { const int kj = tid >> 2, dk0 = (tid & 3) * 16; const bf16_t* ksrc = (const bf16_t*)(P.ws + OFF_PBUF) + (size_t)gla_row(b, c, kj) * PW + 768 + h * 64 + dk0;
      p_k0 = *(const uint4*)(ksrc); p_k1 = *(const uint4*)(ksrc + 8); }
}
DEV void gla_stage_gate_regs(const float4& x, const float4& wv4, bf16_t* lrA, bf16_t* wB, int tid) {
    {
        const int i = tid >> 2, r0 = (tid & 3) * 4;
        const bf16_t h0 = f2bf(x.x), h1 = f2bf(x.y), h2 = f2bf(x.z), h3 = f2bf(x.w);
        uint2 hi, lo; hi.x = (unsigned)h0 | ((unsigned)h1 << 16); hi.y = (unsigned)h2 | ((unsigned)h3 << 16);
        lo.x = pack2(x.x - bf2f(h0), x.y - bf2f(h1)); lo.y = pack2(x.z - bf2f(h2), x.w - bf2f(h3));
        *(uint2*)(lrA + i * 40 + r0) = hi; *(uint2*)(lrA + i * 40 + 16 + r0) = lo;
    }
    {
        const int dk = tid & 63, rq = (tid >> 6) * 4;
        const float wv[4] = {wv4.x, wv4.y, wv4.z, wv4.w};
#pragma unroll
        for (int u = 0; u < 4; ++u) { const bf16_t hv = f2bf(wv[u]); wB[dk * 40 + rq + u] = hv; wB[dk * 40 + 16 + rq + u] = f2bf(wv[u] - bf2f(hv)); }
    }
}
DEV void gla_local_item(const Params& P, int l, int item, unsigned char* smem, int tid, const float4& p_lr, const float4& p_w, const uint4& p_v0, const uint4& p_v1, const uint4& p_v2, const uint4& p_v3, const uint4& w0, const uint4& w1) {
    const int d = item & 1, c = (item >> 1) % NCH, bh = (item >> 1) / NCH, h = bh & 3, b = bh >> 2;
    float* gc = (float*)smem; bf16_t* kd = (bf16_t*)(smem + 16384); bf16_t* Vs = (bf16_t*)(smem + 28672);
    bf16_t* lrA = (bf16_t*)(smem + 49152); bf16_t* wB = (bf16_t*)(smem + 54272); float* tot_s = (float*)(smem + 59392);
    gla_stage_gate_regs(p_lr, p_w, lrA, wB, tid);
    { const int i = tid >> 2, dv0 = (tid & 3) * 32; bf16_t* dst = Vs + i * 160 + dv0; *(uint4*)(dst) = p_v0; *(uint4*)(dst + 8) = p_v1; *(uint4*)(dst + 16) = p_v2; *(uint4*)(dst + 24) = p_v3; }
    const int chain = (b * 4 + h) * 2 + d;
    const int kj = tid >> 2, dk0 = (tid & 3) * 16;
    __syncthreads();
    gla_gc_mfma(P, l, d, h, lrA, wB, gc, tot_s, tid);
    {
        const unsigned ww[8] = {w0.x, w0.y, w0.z, w0.w, w1.x, w1.y, w1.z, w1.w};
        const float* gtot = gc + (d == 0 ? 63 * 64 : 0);
        unsigned ko[8];
#pragma unroll
        for (int e = 0; e < 8; ++e) {
            const int dk = dk0 + 2 * e;
            const float k0 = __uint_as_float(ww[e] << 16), k1 = __uint_as_float(ww[e] & 0xffff0000u);
            ko[e] = pack2(k0 * __builtin_amdgcn_exp2f(gtot[dk] - gc[kj * 64 + dk]), k1 * __builtin_amdgcn_exp2f(gtot[dk + 1] - gc[kj * 64 + dk + 1]));
        }
        *(uint4*)(kd + kj * 96 + dk0) = make_uint4(ko[0], ko[1], ko[2], ko[3]); *(uint4*)(kd + kj * 96 + dk0 + 8) = make_uint4(ko[4], ko[5], ko[6], ko[7]);
        if (tid < 64) ((float*)(P.ws + OFF_DEC))[(size_t)(chain * NCH + c) * 64 + tid] = __builtin_amdgcn_exp2f(gtot[tid]);
    }
    __syncthreads();
    const int lane = tid & 63, w = tid >> 6, fr = lane & 31, hh = lane >> 5;
    f32x16 acc[2];
#pragma unroll
    for (int nj = 0; nj < 2; ++nj)
#pragma unroll
        for (int r = 0; r < 16; ++r) acc[nj][r] = 0.f;
#pragma unroll
    for (int ks = 0; ks < 4; ++ks) {
        const bf16x8 bv = tr_frag(Vs, 160, w * 32, ks * 16, lane);
        const bf16x8 a0 = tr_frag(kd, 96, 0, ks * 16, lane), a1 = tr_frag(kd, 96, 32, ks * 16, lane);
        acc[0] = __builtin_amdgcn_mfma_f32_32x32x16_bf16(a0, bv, acc[0], 0, 0, 0);
        acc[1] = __builtin_amdgcn_mfma_f32_32x32x16_bf16(a1, bv, acc[1], 0, 0, 0);
    }
    bf16_t* ds = (bf16_t*)(P.ws + OFF_DS) + (size_t)(chain * NCH + c) * 8192 + (w * 32 + fr) * 64;
#pragma unroll
    for (int nj = 0; nj < 2; ++nj)
#pragma unroll
        for (int g = 0; g < 4; ++g) {
            uint2 o; o.x = pack2(acc[nj][4 * g], acc[nj][4 * g + 1]); o.y = pack2(acc[nj][4 * g + 2], acc[nj][4 * g + 3]);
            *(uint2*)(ds + nj * 32 + 8 * g + 4 * hh) = o;
        }
    __syncthreads();
}
constexpr int PC_S5 = 32 * 9 * 2, PC_GLA = NB * 4 * NCH * 2;
DEV void phase_C(const Params& P, int l, unsigned char* smem, int tid_, int bid, int nb) {
    const int tid_in = tid_;
    {
        float4 a_lr, a_w, b_lr, b_w; uint4 a_v0, a_v1, a_v2, a_v3, a_k0, a_k1, b_v0, b_v1, b_v2, b_v3, b_k0, b_k1;
        a_lr = a_w = b_lr = b_w = make_float4(0.f, 0.f, 0.f, 0.f); a_v0 = a_v1 = a_v2 = a_v3 = a_k0 = a_k1 = b_v0 = b_v1 = b_v2 = b_v3 = b_k0 = b_k1 = make_uint4(0u, 0u, 0u, 0u);
        int it = bid;
        if (it < PC_GLA) gla_local_load(P, l, it, tid_in, a_lr, a_w, a_v0, a_v1, a_v2, a_v3, a_k0, a_k1);
        while (it < PC_GLA) {
            { int tid = tid_in; asm volatile("" : "+v"(tid));
              const int nx = it + nb; if (nx < PC_GLA) gla_local_load(P, l, nx, tid, b_lr, b_w, b_v0, b_v1, b_v2, b_v3, b_k0, b_k1);
              gla_local_item(P, l, it, smem, tid, a_lr, a_w, a_v0, a_v1, a_v2, a_v3, a_k0, a_k1); it = nx; }
            if (it >= PC_GLA) break;
            { int tid = tid_in; asm volatile("" : "+v"(tid));
              const int nx = it + nb; if (nx < PC_GLA) gla_local_load(P, l, nx, tid, a_lr, a_w, a_v0, a_v1, a_v2, a_v3, a_k0, a_k1);
              gla_local_item(P, l, it, smem, tid, b_lr, b_w, b_v0, b_v1, b_v2, b_v3, b_k0, b_k1); it = nx; }
        }
    }
    int tid = tid_in; asm volatile("" : "+v"(tid));
    GR_DECL bool pre = false;
    auto mk = [&](int item, GemmDesc& G, EpiHloc& epi, int& m0, int& n0) {
        const int j = item >> 3, g = (j / 18) * 8 + (item & 7), mt = (j % 18) >> 1, nt = j & 1;
        G.A = (const bf16_t*)(P.ws + OFF_ABUF) + (size_t)g * NSUB * 768; G.lda = 768; G.M = NSUB;
        G.B = (const bf16_t*)(P.ws + OFF_MH) + (size_t)g * 256 * 512; G.ldb = 512; G.N = 256; G.K = 512;
        epi.hloc = (float*)(P.ws + OFF_HY) + (size_t)g * NSUB * 256; m0 = mt * 128; n0 = nt * 128;
    };
    for (int item = nb - 1 - bid; item < PC_S5; item += nb) {
        GemmDesc G, Gn; EpiHloc epi, epin; int m0, n0, m0n, n0n; const int nx = item + nb; const bool hn = nx < PC_S5;
        mk(item, G, epi, m0, n0); mk(hn ? nx : item, Gn, epin, m0n, n0n);
        gemm_tile(G, m0, n0, epi, GR_ARGS, pre, hn, Gn, m0n, n0n, smem, tid); pre = hn;
    }
}

DEV void s5_scan_item(const Params& P, int l, int item, int tid) {
    const int idx = item * 256 + tid, n = idx & 63, d = (idx >> 6) & 1, g = (idx >> 7) & 31, b = idx >> 12;
    const float* lamT = (const float*)(P.ws + OFF_LAMT) + (size_t)(((l * 2 + d) * 32 + g) * 64 + n) * 2;
    const float ltr = lamT[0], lti = lamT[1];
    const float* __restrict__ hloc = (const float*)(P.ws + OFF_HY) + (size_t)g * NSUB * 256 + d * 128 + n;
    bf16_t* __restrict__ hin = (bf16_t*)(P.ws + OFF_ABUF) + (size_t)g * NSUB * 768 + 512 + d * 128 + n;
    float hr = 0.f, hi = 0.f;
    for (int s0 = 0; s0 < 264; s0 += 24) {
        float lr_[24], li_[24]; int sub[24];
#pragma unroll
        for (int u = 0; u < 24; ++u) {
            const int step = s0 + u;
            sub[u] = step < 8 ? b * 8 + (d == 0 ? step : 7 - step) : 32 + b * 256 + (d == 0 ? step - 8 : 263 - step);
            lr_[u] = hloc[(size_t)sub[u] * 256]; li_[u] = hloc[(size_t)sub[u] * 256 + 64];
        }
#pragma unroll
        for (int u = 0; u < 24; ++u) {
            hin[(size_t)sub[u] * 768] = f2bf(hr); hin[(size_t)sub[u] * 768 + 64] = f2bf(hi);
            const float nr = ltr * hr - lti * hi + lr_[u], ni = ltr * hi + lti * hr + li_[u];
            hr = nr; hi = ni;
        }
    }
}
DEV int gla_chain_chunk(int d, int step) { return d == 0 ? step : (step < 4 ? 3 - step : 135 - step); }
DEV void gla_scan_item(const Params& P, int item, int tid) {
    const int chain = item >> 4, e2 = (item & 15) * 256 + tid, dk = (e2 * 2) & 63, d = chain & 1;
    unsigned* ds = (unsigned*)(P.ws + OFF_DS) + (size_t)chain * NCH * 4096 + e2;
    const float* dec = (const float*)(P.ws + OFF_DEC) + (size_t)chain * NCH * 64 + dk;
    float s0 = 0.f, s1 = 0.f;
    for (int st = 0; st < NCH; st += 12) {
        unsigned t[12]; float2 dc[12]; int c[12];
#pragma unroll
        for (int u = 0; u < 12; ++u) { c[u] = gla_chain_chunk(d, st + u); t[u] = ds[(size_t)c[u] * 4096]; dc[u] = *(const float2*)(dec + c[u] * 64); }
#pragma unroll
        for (int u = 0; u < 12; ++u) {
            ds[(size_t)c[u] * 4096] = pack2(s0, s1);
            s0 = dc[u].x * s0 + __uint_as_float(t[u] << 16); s1 = dc[u].y * s1 + __uint_as_float(t[u] & 0xffff0000u);
        }
    }
}
constexpr int PD_S5 = 64, PD_GLA = 32 * 16;
DEV void phase_D(const Params& P, int l, int tid, int bid, int nb) {
    const int total = PD_S5 + PD_GLA;
    for (int it = bid; it < total; it += nb) { if (it < PD_S5) s5_scan_item(P, l, it, tid); else gla_scan_item(P, it - PD_S5, tid); }
}

DEV void gla_out_item(const Params& P, int l, int item, unsigned char* smem, int tid) {
    const int c = item % NCH, bh = item / NCH, h = bh & 3, b = bh >> 2;
    float* gc = (float*)smem; bf16_t* qt = (bf16_t*)(smem + 16384); bf16_t* kt = (bf16_t*)(smem + 25600); bf16_t* Pm = (bf16_t*)(smem + 34816);
    bf16_t* Vs = (bf16_t*)(smem + 44032); bf16_t* lrA = (bf16_t*)(smem + 64512); bf16_t* wB = (bf16_t*)(smem + 69632); float* tot_s = (float*)(smem + 74752);
    float* o_s = (float*)smem;
    const int lane = tid & 63, w = tid >> 6, fr = lane & 31, hh = lane >> 5, fh = hh * 8;
    f32x16 acco[2];
#pragma unroll
    for (int mi = 0; mi < 2; ++mi)
#pragma unroll
        for (int r = 0; r < 16; ++r) acco[mi][r] = 0.f;
    gla_load_v(P, b, c, h, Vs, tid);
    for (int d = 0; d < 2; ++d) {
        const int chain = (b * 4 + h) * 2 + d;
        gla_stage_gate(P, l, b, c, d, h, lrA, wB, tid);
        const bf16_t* sp = (const bf16_t*)(P.ws + OFF_DS) + (size_t)(chain * NCH + c) * 8192 + (w * 32 + fr) * 64 + fh;
        bf16x8 sf[4];
#pragma unroll
        for (int ks = 0; ks < 4; ++ks) sf[ks] = *(const bf16x8*)(sp + ks * 16);
        const int qi = tid >> 2, dk0 = (tid & 3) * 16;
        const bf16_t* qsrc = (const bf16_t*)(P.ws + OFF_PBUF) + (size_t)gla_row(b, c, qi) * PW + 512 + h * 64 + dk0;
        const uint4 q0 = *(const uint4*)(qsrc), q1 = *(const uint4*)(qsrc + 8), k0 = *(const uint4*)(qsrc + 256), k1 = *(const uint4*)(qsrc + 264);
        __syncthreads();
        gla_gc_mfma(P, l, d, h, lrA, wB, gc, tot_s, tid);
        {
            const unsigned qq[8] = {q0.x, q0.y, q0.z, q0.w, q1.x, q1.y, q1.z, q1.w}, kk[8] = {k0.x, k0.y, k0.z, k0.w, k1.x, k1.y, k1.z, k1.w};
            unsigned qo[8], ko[8];
#pragma unroll
            for (int e = 0; e < 8; ++e) {
                const float g0 = gc[qi * 64 + dk0 + 2 * e], g1 = gc[qi * 64 + dk0 + 2 * e + 1];
                const float e0 = __builtin_amdgcn_exp2f(g0), e1 = __builtin_amdgcn_exp2f(g1), n0 = __builtin_amdgcn_exp2f(-g0), n1 = __builtin_amdgcn_exp2f(-g1);
                qo[e] = pack2(__uint_as_float(qq[e] << 16) * 0.125f * e0, __uint_as_float(qq[e] & 0xffff0000u) * 0.125f * e1);
                ko[e] = pack2(__uint_as_float(kk[e] << 16) * n0, __uint_as_float(kk[e] & 0xffff0000u) * n1);
            }
            *(uint4*)(qt + qi * 72 + dk0) = make_uint4(qo[0], qo[1], qo[2], qo[3]); *(uint4*)(qt + qi * 72 + dk0 + 8) = make_uint4(qo[4], qo[5], qo[6], qo[7]);
            *(uint4*)(kt + qi * 72 + dk0) = make_uint4(ko[0], ko[1], ko[2], ko[3]); *(uint4*)(kt + qi * 72 + dk0 + 8) = make_uint4(ko[4], ko[5], ko[6], ko[7]);
        }
        __syncthreads();
        {
            const int mj = w >> 1, ni = w & 1;
            f32x16 sc;
#pragma unroll
            for (int r = 0; r < 16; ++r) sc[r] = 0.f;
#pragma unroll
            for (int ks = 0; ks < 4; ++ks) {
                const bf16x8 a = *(const bf16x8*)(kt + (mj * 32 + fr) * 72 + ks * 16 + fh), bb = *(const bf16x8*)(qt + (ni * 32 + fr) * 72 + ks * 16 + fh);
                sc = __builtin_amdgcn_mfma_f32_32x32x16_bf16(a, bb, sc, 0, 0, 0);
            }
            const int i = ni * 32 + fr;
#pragma unroll
            for (int g = 0; g < 4; ++g) {
                const int j0 = mj * 32 + 8 * g + 4 * hh;
                float v[4];
#pragma unroll
                for (int jj = 0; jj < 4; ++jj) { const bool keep = d == 0 ? (j0 + jj <= i) : (j0 + jj >= i); v[jj] = keep ? sc[4 * g + jj] : 0.f; }
                uint2 o; o.x = pack2(v[0], v[1]); o.y = pack2(v[2], v[3]);
                *(uint2*)(Pm + i * 72 + j0) = o;
            }
        }
        __syncthreads();
#pragma unroll
        for (int ks = 0; ks < 4; ++ks) {
            const bf16x8 bv = tr_frag(Vs, 160, w * 32, ks * 16, lane);
            const bf16x8 bs = sf[ks];
            const bf16x8 p0 = *(const bf16x8*)(Pm + fr * 72 + ks * 16 + fh), p1 = *(const bf16x8*)(Pm + (32 + fr) * 72 + ks * 16 + fh);
            const bf16x8 a0 = *(const bf16x8*)(qt + fr * 72 + ks * 16 + fh), a1 = *(const bf16x8*)(qt + (32 + fr) * 72 + ks * 16 + fh);
            acco[0] = __builtin_amdgcn_mfma_f32_32x32x16_bf16(p0, bv, acco[0], 0, 0, 0);
            acco[1] = __builtin_amdgcn_mfma_f32_32x32x16_bf16(p1, bv, acco[1], 0, 0, 0);
            acco[0] = __builtin_amdgcn_mfma_f32_32x32x16_bf16(a0, bs, acco[0], 0, 0, 0);
            acco[1] = __builtin_amdgcn_mfma_f32_32x32x16_bf16(a1, bs, acco[1], 0, 0, 0);
        }
        __syncthreads();
    }
#pragma unroll
    for (int mi = 0; mi < 2; ++mi)
#pragma unroll
        for (int r = 0; r < 16; ++r) { const int i = mi * 32 + (r & 3) + 8 * (r >> 2) + 4 * (lane >> 5); o_s[i * 132 + w * 32 + fr] = acco[mi][r]; }
    __syncthreads();
    {
        const int i = tid >> 2, dv0 = (tid & 3) * 32;
        float ov[32]; float ss = 0.f;
#pragma unroll
        for (int u = 0; u < 8; ++u) { const float4 f = *(const float4*)(o_s + i * 132 + dv0 + u * 4); ov[u * 4] = f.x; ov[u * 4 + 1] = f.y; ov[u * 4 + 2] = f.z; ov[u * 4 + 3] = f.w;
            ss += f.x * f.x + f.y * f.y + f.z * f.z + f.w * f.w; }
        ss += __shfl_xor(ss, 1); ss += __shfl_xor(ss, 2);
        const float rstd = rsqrtf(ss * (1.f / 128.f) + 1e-6f);
        const int row = gla_row(b, c, i);
        const bf16_t* zg = (const bf16_t*)(P.ws + OFF_PBUF) + (size_t)row * PW + 1536 + h * 128 + dv0;
        const float* gn = P.in[I_GNORM] + l * 128 + dv0;
        bf16_t* mo = (bf16_t*)(P.ws + OFF_HMIX) + (size_t)row * D + 512 + h * 128 + dv0;
#pragma unroll
        for (int u = 0; u < 4; ++u) {
            const uint4 z = *(const uint4*)(zg + u * 8); const unsigned zz[4] = {z.x, z.y, z.z, z.w}; unsigned oo[4];
#pragma unroll
            for (int e = 0; e < 4; ++e) {
                const float z0 = __uint_as_float(zz[e] << 16), z1 = __uint_as_float(zz[e] & 0xffff0000u);
                oo[e] = pack2(ov[u * 8 + 2 * e] * rstd * gn[u * 8 + 2 * e] * siluf_(z0), ov[u * 8 + 2 * e + 1] * rstd * gn[u * 8 + 2 * e + 1] * siluf_(z1));
            }
            *(uint4*)(mo + u * 8) = make_uint4(oo[0], oo[1], oo[2], oo[3]);
        }
    }
    __syncthreads();
}
constexpr int PE_S5 = 32 * 9 * 4, PE_GLA = NB * 4 * NCH;
DEV void phase_E(const Params& P, int l, unsigned char* smem, int tid_, int bid, int nb) {
    const int tid_in = tid_;
    for (int it = bid; it < PE_GLA; it += nb) { int tid = tid_in; asm volatile("" : "+v"(tid)); gla_out_item(P, l, it, smem, tid); }
    int tid = tid_in; asm volatile("" : "+v"(tid));
    GR_DECL bool pre = false;
    auto mk = [&](int item, GemmDesc& G, EpiS5Out& epi, int& m0, int& n0) {
        const int j = item >> 3, g = (j / 36) * 8 + (item & 7), mt = (j % 36) >> 2, nt = j & 3;
        G.A = (const bf16_t*)(P.ws + OFF_ABUF) + (size_t)g * NSUB * 768; G.lda = 768; G.M = NSUB;
        G.B = (const bf16_t*)(P.ws + OFF_MY) + (size_t)g * 512 * 768; G.ldb = 768; G.N = 512; G.K = 768;
        epi.ybuf = (bf16_t*)(P.ws + OFF_HY); epi.g = g; m0 = mt * 128; n0 = nt * 128;
    };
    for (int item = nb - 1 - bid; item < PE_S5; item += nb) {
        GemmDesc G, Gn; EpiS5Out epi, epin; int m0, n0, m0n, n0n; const int nx = item + nb; const bool hn = nx < PE_S5;
        mk(item, G, epi, m0, n0); mk(hn ? nx : item, Gn, epin, m0n, n0n);
        gemm_tile(G, m0, n0, epi, GR_ARGS, pre, hn, Gn, m0n, n0n, smem, tid); pre = hn;
    }
}

DEV void phase_F(const Params& P, int l, unsigned char* smem, int tid, int bid, int nb) {
    GemmDesc G; G.A = (const bf16_t*)(P.ws + OFF_HY); G.lda = 512; G.M = NTOK; G.B = (const bf16_t*)(P.ws + OFF_WGLU) + (size_t)l * 512 * 512; G.ldb = 512; G.N = 512; G.K = 512;
    EpiGlu epi; epi.ybuf = (const bf16_t*)(P.ws + OFF_HY); epi.pbuf = (const bf16_t*)(P.ws + OFF_PBUF); epi.bglu = P.in[I_BGLU] + l * 512; epi.mix = (bf16_t*)(P.ws + OFF_HMIX);
    const int total = (NTOK / 128) * 4;
    GR_DECL bool pre = false;
    for (int it = bid + (l == DEPTH - 1 ? 32 : 0); it < total; it += nb) {
        const int j = it >> 3, nx = it + nb, jn = nx >> 3; const bool hn = nx < total;
        gemm_tile(G, ((j >> 2) * 8 + (it & 7)) * 128, (j & 3) * 128, epi, GR_ARGS, pre, hn, G, ((jn >> 2) * 8 + (nx & 7)) * 128, (jn & 3) * 128, smem, tid); pre = hn;
    }
}
DEV void phase_G(const Params& P, int l, unsigned char* smem, int tid, int bid, int nb) {
    GemmDesc G; G.A = (const bf16_t*)(P.ws + OFF_HMIX); G.lda = D; G.M = NTOK; G.B = (const bf16_t*)(P.ws + OFF_WOUT) + (size_t)l * D * D; G.ldb = D; G.N = D; G.K = D;
    EpiOut epi; epi.mod = (const float*)(P.ws + OFF_MOD) + (size_t)l * 5 * 3072; epi.l = l;
    epi.xr_ctx = P.in[I_CTX]; epi.xr_lat = P.in[I_X]; epi.xb_r = (const bf16_t*)(P.ws + OFF_XB); epi.xb_w = (bf16_t*)(P.ws + OFF_XB); epi.out_lat = P.out;
    const int total = (NTOK / 128) * 8;
    GR_DECL bool pre = false;
    for (int it = bid + (l == DEPTH - 1 ? 64 : 0); it < total; it += nb) {
        const int j = it >> 3, nx = it + nb, jn = nx >> 3; const bool hn = nx < total;
        gemm_tile(G, ((j >> 3) * 8 + (it & 7)) * 128, (j & 7) * 128, epi, GR_ARGS, pre, hn, G, ((jn >> 3) * 8 + (nx & 7)) * 128, (jn & 7) * 128, smem, tid); pre = hn;
    }
}
DEV void phase_final(const Params& P, int tid, int bid, int nb) {
    const int total = NB * SEQ / 4;
    for (int it = bid; it < total; it += nb) {
        const int row = it * 4 + (tid >> 6), lane = tid & 63;
        float* x = P.out + (size_t)row * D;
        float4 v[4]; float ss = 0.f;
#pragma unroll
        for (int i = 0; i < 4; ++i) { v[i] = *(const float4*)(x + (i * 64 + lane) * 4); ss += v[i].x * v[i].x + v[i].y * v[i].y + v[i].z * v[i].z + v[i].w * v[i].w; }
#pragma unroll
        for (int o = 32; o >= 1; o >>= 1) ss += __shfl_xor(ss, o);
        const float rstd = rsqrtf(ss * (1.f / 1024.f) + 1e-6f);
#pragma unroll
        for (int i = 0; i < 4; ++i) {
            const int c = (i * 64 + lane) * 4; const float4 g = *(const float4*)(P.in[I_FNORM] + c);
            float4 o; o.x = v[i].x * rstd * g.x; o.y = v[i].y * rstd * g.y; o.z = v[i].z * rstd * g.z; o.w = v[i].w * rstd * g.w;
            *(float4*)(x + c) = o;
        }
    }
}


#define XB_TMO      128
#define XB_XCNT(j)  (256  + 64 * (j))
#define XB_XSUB(j)  (1280 + 64 * (j))
#define XB_XGEN(j)  (2304 + 64 * (j))
#define XB_TOP      3328
#define XB_TOPGEN   3392
#define XCD_BAR_WORDS 3456
#define XB_SPIN_CAP (1u << 20)
DEV unsigned xb_ld(unsigned* p)              { return __hip_atomic_load(p, __ATOMIC_RELAXED, __HIP_MEMORY_SCOPE_AGENT); }
DEV unsigned xb_add(unsigned* p, unsigned v) { return __hip_atomic_fetch_add(p, v, __ATOMIC_RELAXED, __HIP_MEMORY_SCOPE_AGENT); }
DEV unsigned xb_xcc_id() { return (unsigned)__builtin_amdgcn_s_getreg((3 << 11) | 20) & 0xFu; }
#define XB_SPIN(cond, bar) do { unsigned _sp = 0; while (cond) { __builtin_amdgcn_s_sleep(1); \
    if ((++_sp & 255u) == 0u) { if (xb_ld(&(bar)[XB_TMO])) break; if (_sp > XB_SPIN_CAP) { atomicAdd(&(bar)[XB_TMO], 1u); break; } } } } while (0)
struct XcdBarrier { unsigned* bar; unsigned x; volatile LAS unsigned* st; };
DEV XcdBarrier xcd_barrier_post(unsigned* bar, volatile LAS unsigned* st) {
    XcdBarrier b; b.bar = bar; b.x = xb_xcc_id(); b.st = st;
    if (threadIdx.x == 0) (void)xb_add(&bar[XB_XCNT(b.x)], 1u);
    return b;
}
DEV void xcd_barrier_complete(unsigned* bar, unsigned x, unsigned& nloc, unsigned& nx) {
    const unsigned G = gridDim.x * gridDim.y * gridDim.z;
    unsigned sum, cnt, mine, sp = 0u;
    for (;;) {
        sum = 0u; cnt = 0u; mine = 0u;
#pragma unroll
        for (unsigned j = 0; j < 16; ++j) { const unsigned c = xb_ld(&bar[XB_XCNT(j)]); sum += c; cnt += (c > 0u) ? 1u : 0u; mine = (j == x) ? c : mine; }
        if (sum == G) break;
        __builtin_amdgcn_s_sleep(1);
        if ((++sp & 255u) == 0u) { if (xb_ld(&bar[XB_TMO])) break; if (sp > XB_SPIN_CAP) { atomicAdd(&bar[XB_TMO], 1u); break; } }
    }
    nloc = mine > 0u ? mine : 1u; nx = cnt > 0u ? cnt : 1u;
}
DEV void xcd_barrier(const XcdBarrier& b) {
    asm volatile("s_waitcnt vmcnt(0)" ::: "memory");
    __syncthreads();
    if (threadIdx.x == 0) {
        unsigned* bar = b.bar;
        __builtin_amdgcn_s_waitcnt(0);
        unsigned nloc = b.st[0], nx = b.st[1];
        if (nloc == 0u) { xcd_barrier_complete(bar, b.x, nloc, nx); b.st[0] = nloc; b.st[1] = nx; }
        const unsigned old = xb_add(&bar[XB_XSUB(b.x)], 1u);
        const unsigned gen = old / nloc;
        if (old + 1u == (gen + 1u) * nloc) {
            __builtin_amdgcn_fence(__ATOMIC_RELEASE, "agent");
            asm volatile("s_waitcnt vmcnt(0)" ::: "memory");
            const unsigned og = xb_add(&bar[XB_TOP], 1u);
            const unsigned tg = og / nx;
            if (og + 1u == (tg + 1u) * nx) xb_add(&bar[XB_TOPGEN], 1u);
            else XB_SPIN(xb_ld(&bar[XB_TOPGEN]) == tg, bar);
            __builtin_amdgcn_fence(__ATOMIC_ACQUIRE, "agent");
            xb_add(&bar[XB_XGEN(b.x)], 1u);
            asm volatile("s_waitcnt vmcnt(0)" ::: "memory");
        } else {
            XB_SPIN(xb_ld(&bar[XB_XGEN(b.x)]) == gen, bar);
            __builtin_amdgcn_fence(__ATOMIC_ACQUIRE, "agent");
            asm volatile("s_waitcnt vmcnt(0)" ::: "memory");
        }
    }
    __syncthreads();
}

__global__ void __launch_bounds__(NTHREADS, 2) fwd_megakernel(Params P, int ph_lo, int ph_hi) {
    extern __shared__ __attribute__((aligned(16))) unsigned char smem[];
    cg::grid_group grid = cg::this_grid();
    const int tid0 = threadIdx.x, bid0 = blockIdx.x, nb0 = gridDim.x;
    volatile LAS unsigned* xst = (volatile LAS unsigned*)(smem + LDS_MAIN);
    if (tid0 < 4) xst[tid0] = 0u;
    __syncthreads();
    const XcdBarrier xb = xcd_barrier_post((unsigned*)(P.ws + OFF_BAR), xst);
    for (int ph = ph_lo; ph < ph_hi; ++ph) {
        int tid = tid0, bid = bid0, nb = nb0;
        asm volatile("" : "+v"(tid)); asm volatile("" : "+s"(bid)); asm volatile("" : "+s"(nb));
        if (ph == 0) { if (PHMASK & 1) { phase_prep(P, smem, tid, bid, nb); if (REPP0) { asm volatile("" : "+v"(tid)); phase_prep(P, smem, tid, bid, nb); } } }
        else if (ph == NPHASE - 1) { if (PHMASK & 256) phase_final(P, tid, bid, nb); }
        else {
            const int l = (ph - 1) / 7, s = (ph - 1) % 7;
            for (int rep = 0; rep < (((REPMASK >> s) & 1) ? 2 : 1); ++rep) {
            asm volatile("" : "+v"(tid)); asm volatile("" : "+s"(bid)); asm volatile("" : "+s"(nb));
            switch (s) {
                case 0: if (PHMASK & 2) phase_A(P, l, tid, bid, nb); break;
                case 1: if (PHMASK & 4) phase_B(P, l, smem, tid, bid, nb); break;
                case 2: if (PHMASK & 8) phase_C(P, l, smem, tid, bid, nb); break;
                case 3: if (PHMASK & 16) phase_D(P, l, tid, bid, nb); break;
                case 4: if (PHMASK & 32) phase_E(P, l, smem, tid, bid, nb); break;
                case 5: if (PHMASK & 64) phase_F(P, l, smem, tid, bid, nb); break;
                default: if (PHMASK & 128) { phase_G(P, l, smem, tid, bid, nb); if (REPG0 && l == 0) phase_G(P, l, smem, tid, bid, nb); } break;
            }
            }
        }
        if (ph + 1 < ph_hi) { if (ph_hi > 4096) grid.sync(); xcd_barrier(xb); }
    }
}

extern "C" void kernel_launch(void* const* d_in, const int* in_sizes, int n_in, void* d_out, int out_size, void* d_ws, size_t ws_size, hipStream_t stream) {
    static int grid_blocks = 0;
    if (grid_blocks == 0) {
        if (n_in != 23 || ws_size < WS_END) { fprintf(stderr, "kernel_launch: unexpected n_in %d or ws_size %zu (< %zu)\n", n_in, ws_size, (size_t)WS_END); grid_blocks = -1; return; }
        int dev = 0, cus = 0, per_cu = 0;
        hipGetDevice(&dev);
        hipDeviceGetAttribute(&cus, hipDeviceAttributeMultiprocessorCount, dev);
        if (hipFuncSetAttribute((const void*)fwd_megakernel, hipFuncAttributeMaxDynamicSharedMemorySize, LDS_BYTES) != hipSuccess) { fprintf(stderr, "kernel_launch: hipFuncSetAttribute failed\n"); grid_blocks = -1; return; }
        if (hipOccupancyMaxActiveBlocksPerMultiprocessor(&per_cu, (const void*)fwd_megakernel, NTHREADS, LDS_BYTES) != hipSuccess || per_cu < 1) { fprintf(stderr, "kernel_launch: occupancy query failed (%d)\n", per_cu); grid_blocks = -1; return; }
        if (per_cu > 2) per_cu = 2;
        grid_blocks = cus * per_cu;
    }
    if (grid_blocks < 0) return;
    Params p{};
    for (int i = 0; i < 23; ++i) p.in[i] = (const float*)d_in[i];
    p.out = (float*)d_out; p.ws = (unsigned char*)d_ws;
    (void)hipMemsetAsync((unsigned char*)d_ws + OFF_BAR, 0, 3456 * 4, stream);
#if MULTI_LAUNCH
    for (int ph = 0; ph < NPHASE; ++ph) hipLaunchKernelGGL(fwd_megakernel, dim3(grid_blocks), dim3(NTHREADS), LDS_BYTES, stream, p, ph, ph + 1);
#else
    int lo = 0, hi = NPHASE;
    void* args[] = {&p, &lo, &hi};
    hipError_t e = hipLaunchCooperativeKernel((const void*)fwd_megakernel, dim3(grid_blocks), dim3(NTHREADS), args, LDS_BYTES, stream);
    if (e != hipSuccess) fprintf(stderr, "cooperative launch failed: %s (grid %d)\n", hipGetErrorString(e), grid_blocks);
#endif
}
```
